# Optimizing an MI355X kernel written in HIP

```python
import jax, jax.numpy as jnp
from jax import lax
import numpy as np

D_MODEL = 2048
BATCH = 1
SEQ = 8192
DEPTH = 1
DEC_BATCH = 32
DEC_SEQ = 8
PAST_LEN = 8192
PAGE_SIZE = 128

HEAD_DIM = 128
N_ATT_HEADS = 8
D_ATT = N_ATT_HEADS * HEAD_DIM
D_CONV = D_MODEL - D_ATT
CONV_WIDTH = 3
DILATED_BRANCHES = ((128, 1), (512, 4), (2048, 16))
MAX_WINDOW = 2048
N_BUCKETS = 32
REL_MAX_DISTANCE = 2048
D_FF = ((8 * D_MODEL + 767) // 768) * 256
D_IN = 3 * D_CONV + 3 * D_ATT
QBLOCK = 128
EPS = 1e-6

kernel_name = "hybrid_shortconv_dilated_swa_step"


def _branch_distances_and_buckets():
    dist = np.stack([np.arange(0, w + 1, d) for (w, d) in DILATED_BRANCHES]).astype(np.int64)
    max_exact = N_BUCKETS // 2
    large = max_exact + (np.log(np.maximum(dist, 1) / max_exact)
                         / np.log(REL_MAX_DISTANCE / max_exact)
                         * (N_BUCKETS - max_exact)).astype(np.int64)
    large = np.minimum(large, N_BUCKETS - 1)
    bucket = np.where(dist < max_exact, dist, large)
    return dist.astype(np.int32), bucket.astype(np.int32)


def rms_norm(x, g):
    xf = x.astype(jnp.float32)
    y = xf * lax.rsqrt(jnp.mean(xf * xf, axis=-1, keepdims=True) + EPS)
    return (y * g.astype(jnp.float32)).astype(x.dtype)


def dilated_attention(q, k_ext, v_ext, qpos, dist, bias):
    idx = qpos[:, None, None] - dist[None]
    valid = idx >= 0
    idx = jnp.maximum(idx, 0)
    kg = jnp.take(k_ext, idx, axis=1, mode="clip")
    vg = jnp.take(v_ext, idx, axis=1, mode="clip")
    logits = jnp.einsum('bqhd,bqgnhd->bqhgn', q, kg).astype(jnp.float32) * (HEAD_DIM ** -0.5)
    logits = logits + bias[None, None]
    logits = jnp.where(valid[None, :, None], logits, -1e30)
    m = jnp.max(logits, axis=-1, keepdims=True)
    p = jnp.exp(logits - m)
    s = jnp.sum(p, axis=-1, keepdims=True)
    o = jnp.einsum('bqhgn,bqgnhd->bqhgd', p, vg.astype(jnp.float32)) / s
    w = jax.nn.softmax((m + jnp.log(s))[..., 0], axis=-1)
    out = jnp.einsum('bqhg,bqhgd->bqhd', w, o)
    return out.astype(q.dtype)


def prompt_attention(q, k, v, dist, bias):
    B, S, H, D = q.shape
    nb = S // QBLOCK
    qb = q.reshape(B, nb, QBLOCK, H, D).transpose(1, 0, 2, 3, 4)
    starts = jnp.arange(nb, dtype=jnp.int32) * QBLOCK

    def block(args):
        qi, st = args
        return dilated_attention(qi, k, v, st + jnp.arange(QBLOCK, dtype=jnp.int32), dist, bias)

    out = lax.map(block, (qb, starts))
    return out.transpose(1, 0, 2, 3, 4).reshape(B, S, H, D)


def layer_forward(x, conv_prev, k_prev, v_prev, norm_mix, w_in, conv_w, q_norm, k_norm,
                  w_out, norm_ffn, w_gate, w_up, w_down, dist, bias):
    B, T, _ = x.shape
    h = rms_norm(x, norm_mix)
    proj = h @ w_in
    xc, bg, cg, q, k, v = jnp.split(
        proj, np.cumsum([D_CONV, D_CONV, D_CONV, D_ATT, D_ATT]).tolist(), axis=-1)
    u = cg * xc
    u_ext = jnp.concatenate([conv_prev, u], axis=1)
    conv = u_ext[:, 0:T] * conv_w[0]
    for j in range(1, CONV_WIDTH):
        conv = conv + u_ext[:, j:j + T] * conv_w[j]
    y_conv = bg * conv
    q = rms_norm(q.reshape(B, T, N_ATT_HEADS, HEAD_DIM), q_norm)
    k = rms_norm(k.reshape(B, T, N_ATT_HEADS, HEAD_DIM), k_norm)
    v = v.reshape(B, T, N_ATT_HEADS, HEAD_DIM)
    if k_prev is None:
        att = prompt_attention(q, k, v, dist, bias)
    else:
        k_ext = jnp.concatenate([k_prev, k], axis=1)
        v_ext = jnp.concatenate([v_prev, v], axis=1)
        qpos = k_prev.shape[1] + jnp.arange(T, dtype=jnp.int32)
        att = dilated_attention(q, k_ext, v_ext, qpos, dist, bias)
    mix = jnp.concatenate([y_conv, att.reshape(B, T, D_ATT)], axis=-1) @ w_out
    x = x + mix
    f = rms_norm(x, norm_ffn)
    x = x + (jax.nn.silu(f @ w_gate) * (f @ w_up)) @ w_down
    new_conv = u_ext[:, -(CONV_WIDTH - 1):]
    return x, new_conv, k, v


def setup_inputs(seed: int = 0) -> dict:
    key = jax.random.key(seed)
    ks = jax.random.split(key, 20)
    w_buf = min(MAX_WINDOW, PAST_LEN)
    f32 = jnp.float32
    nrm = lambda k, shape, s: jax.random.normal(k, shape, f32) * s
    return {
        "x_prompt": nrm(ks[0], (BATCH, SEQ, D_MODEL), 1.0),
        "x_sample": nrm(ks[1], (DEC_BATCH, DEC_SEQ, D_MODEL), 1.0),
        "cache_k": nrm(ks[2], (DEPTH, DEC_BATCH, w_buf, N_ATT_HEADS, HEAD_DIM), 1.0),
        "cache_v": nrm(ks[3], (DEPTH, DEC_BATCH, w_buf, N_ATT_HEADS, HEAD_DIM), 1.0),
        "state_conv": nrm(ks[4], (DEPTH, DEC_BATCH, CONV_WIDTH - 1, D_CONV), 1.0),
        "norm_mix": 1.0 + nrm(ks[5], (DEPTH, D_MODEL), 0.02),
        "w_in": nrm(ks[6], (DEPTH, D_MODEL, D_IN), D_MODEL ** -0.5),
        "conv_w": nrm(ks[7], (DEPTH, CONV_WIDTH, D_CONV), CONV_WIDTH ** -0.5),
        "q_norm": 1.0 + nrm(ks[8], (DEPTH, HEAD_DIM), 0.02),
        "k_norm": 1.0 + nrm(ks[9], (DEPTH, HEAD_DIM), 0.02),
        "rel_bias": nrm(ks[10], (N_BUCKETS, N_ATT_HEADS), 0.1),
        "w_out": nrm(ks[11], (DEPTH, D_MODEL, D_MODEL), D_MODEL ** -0.5),
        "norm_ffn": 1.0 + nrm(ks[12], (DEPTH, D_MODEL), 0.02),
        "w_gate": nrm(ks[13], (DEPTH, D_MODEL, D_FF), D_MODEL ** -0.5),
        "w_up": nrm(ks[14], (DEPTH, D_MODEL, D_FF), D_MODEL ** -0.5),
        "w_down": nrm(ks[15], (DEPTH, D_FF, D_MODEL), D_FF ** -0.5),
    }


def reference(x_prompt, x_sample, cache_k, cache_v, state_conv, norm_mix, w_in, conv_w,
              q_norm, k_norm, rel_bias, w_out, norm_ffn, w_gate, w_up, w_down):
    dist_np, bucket_np = _branch_distances_and_buckets()
    dist = jnp.asarray(dist_np)
    bias = rel_bias.astype(jnp.float32)[jnp.asarray(bucket_np)].transpose(2, 0, 1)
    prompt_keep = min(MAX_WINDOW, x_prompt.shape[1])
    xp, xs = x_prompt, x_sample
    pk, pv, pc, sk, sv, sc = [], [], [], [], [], []
    for l in range(DEPTH):
        lw = (norm_mix[l], w_in[l], conv_w[l], q_norm[l], k_norm[l], w_out[l], norm_ffn[l],
              w_gate[l], w_up[l], w_down[l], dist, bias)
        conv0 = jnp.zeros((xp.shape[0], CONV_WIDTH - 1, D_CONV), xp.dtype)
        xp, c_p, k_p, v_p = layer_forward(xp, conv0, None, None, *lw)
        xs, c_s, k_s, v_s = layer_forward(xs, state_conv[l], cache_k[l], cache_v[l], *lw)
        pk.append(k_p[:, -prompt_keep:])
        pv.append(v_p[:, -prompt_keep:])
        pc.append(c_p)
        sk.append(k_s)
        sv.append(v_s)
        sc.append(c_s)
    return (xp, xs, jnp.stack(pk), jnp.stack(pv), jnp.stack(pc),
            jnp.stack(sk), jnp.stack(sv), jnp.stack(sc))
```

```cpp
#include <hip/hip_runtime.h>
#include <hip/hip_cooperative_groups.h>
#include <cstdio>
#include <cstdint>

constexpr int DM = 2048, SEQ = 8192, DBATCH = 32, DSEQ = 8, NSAMP = DBATCH * DSEQ, MT = SEQ + NSAMP;
constexpr int HD = 128, NH = 8, DATT = 1024, DCONV = 1024, DFF = 5632, DIN = 6144, WBUF = 2048, NGU = 2 * DFF;
constexpr float EPS = 1e-6f;
constexpr float LOG2E = 1.4426950408889634f;
constexpr float QSCALE = 0.08838834764831845f * LOG2E;

__device__ const unsigned char BUCKET[3][132] __attribute__((aligned(16))) = {
{0,1,2,3,4,5,6,7,8,9,10,11,12,13,14,15,16,16,16,16,16,16,17,17,17,17,17,17,17,17,18,18,18,18,18,18,18,18,18,18,19,19,19,19,19,19,19,19,19,19,19,19,19,19,20,20,20,20,20,20,20,20,20,20,20,20,20,20,20,20,20,20,20,21,21,21,21,21,21,21,21,21,21,21,21,21,21,21,21,21,21,21,21,21,21,21,21,21,21,22,22,22,22,22,22,22,22,22,22,22,22,22,22,22,22,22,22,22,22,22,22,22,22,22,22,22,22,22,22,0,0,0},
{0,4,8,12,16,16,17,17,18,18,19,19,19,19,20,20,20,20,20,21,21,21,21,21,21,22,22,22,22,22,22,22,22,22,23,23,23,23,23,23,23,23,23,23,23,23,24,24,24,24,24,24,24,24,24,24,24,24,24,24,24,24,25,25,25,25,25,25,25,25,25,25,25,25,25,25,25,25,25,25,25,25,25,26,26,26,26,26,26,26,26,26,26,26,26,26,26,26,26,26,26,26,26,26,26,26,26,26,26,26,26,26,26,27,27,27,27,27,27,27,27,27,27,27,27,27,27,27,27,0,0,0},
{0,16,18,19,20,21,21,22,22,23,23,23,24,24,24,24,25,25,25,25,25,26,26,26,26,26,26,26,26,27,27,27,27,27,27,27,27,27,27,28,28,28,28,28,28,28,28,28,28,28,28,28,29,29,29,29,29,29,29,29,29,29,29,29,29,29,29,29,29,29,30,30,30,30,30,30,30,30,30,30,30,30,30,30,30,30,30,30,30,30,30,30,30,30,30,31,31,31,31,31,31,31,31,31,31,31,31,31,31,31,31,31,31,31,31,31,31,31,31,31,31,31,31,31,31,31,31,31,31,0,0,0}};

#ifndef REP_E1
#define REP_E1 1
#endif
#ifndef REP_E2
#define REP_E2 1
#endif
#ifndef REP_E3
#define REP_E3 1
#endif
#ifndef REP_E4
#define REP_E4 1
#endif
namespace pg8 {
#define PG8_LAS __attribute__((address_space(3)))
typedef unsigned short bf16_t;
typedef short bf16x8 __attribute__((ext_vector_type(8)));
typedef float f32x4 __attribute__((ext_vector_type(4)));
typedef unsigned u32x4 __attribute__((ext_vector_type(4)));
typedef unsigned u32x2 __attribute__((ext_vector_type(2)));
constexpr int BM = 256, BK = 64, HALF = 128, HTB = HALF * BK * 2  , STAGE_BYTES = 8 * HTB, NXCD = 8, WGM = 8;

__host__ __device__ __forceinline__ int lds_byte(int r, int c) { const int st = (r >> 4) * 2 + (c >> 5), rr = r & 15, cc = c & 31, ob = rr * 64 + cc * 2; return st * 1024 + (ob ^ (((ob >> 9) & 1) << 5)); }
__host__ __device__ __forceinline__ void stage_rc(int b, int& R, int& C) { const int st = b / 1024, sb = b % 1024, swz = sb ^ (((sb >> 9) & 1) << 5); R = (st >> 1) * 16 + swz / 64; C = (st & 1) * 32 + (swz % 64) / 2; }
__host__ __device__ __forceinline__ int perm32(int rho) { const int n = rho >> 4, i = rho & 15; return 8 * (i >> 2) + 4 * n + (i & 3); }

struct Unit { int pm, pn; };
struct Gemm { const bf16_t* A; const bf16_t* Bt; int M, N, K; };

struct StaticOrder {
    int nM, nN, nwg, G, c;
    __host__ __device__ void init(int M, int N, int G_, int c_) { nM = M / BM; nN = N / BM; nwg = nM * nN; G = G_; c = c_; }
    __host__ __device__ bool next(int i, Unit& u) const {
        const long L = (long)i * G + c; if (L >= nwg) return false;
        int wgid = (int)L; { const int q = nwg / NXCD, r = nwg % NXCD, xcd = wgid % NXCD, off = wgid / NXCD; wgid = (xcd < r ? xcd * (q + 1) : r * (q + 1) + (xcd - r) * q) + off; }
        const int nig = WGM * nN, gid = wgid / nig, fm = gid * WGM, gsz = (nM - fm) < WGM ? (nM - fm) : WGM;
        u.pm = fm + ((wgid % nig) % gsz); u.pn = (wgid % nig) / gsz; return true;
    }
    __device__ __forceinline__ void a_ready(const Unit&) const {}
    __device__ __forceinline__ void done(const Unit&) const {}
};

__device__ __forceinline__ unsigned cvt_pk_bf16(float lo, float hi) { unsigned r; asm volatile("v_cvt_pk_bf16_f32 %0, %1, %2" : "=v"(r) : "v"(lo), "v"(hi)); return r; }

constexpr int EPI_BUF0 = 3 * HTB  , EPI_BUF1 = 143360;
__device__ __forceinline__ void rg_store_bf16(PG8_LAS unsigned char* buf, u32x4 w0, u32x4 w1, int wr, int wc, int fr, int fq, bf16_t* grow, size_t ld) {
    PG8_LAS unsigned char* g = buf + wr * 8192;
    *(PG8_LAS u32x4*)(g + fr * 512 + 16 * ((4 * wc + fq) ^ fr)) = w0;
    *(PG8_LAS u32x4*)(g + fr * 512 + 16 * (16 + ((4 * wc + fq) ^ fr))) = w1;
    asm volatile("s_waitcnt lgkmcnt(0)" ::: "memory"); __builtin_amdgcn_s_barrier(); asm volatile("" ::: "memory");
    const int lane = fr + 16 * fq, chunk = lane & 31;
#pragma unroll
    for (int i = 0; i < 2; ++i) { const int row = 4 * wc + 2 * i + (lane >> 5);
        const u32x4 v = *(const PG8_LAS u32x4*)(g + row * 512 + 16 * (chunk ^ row));
        *(u32x4*)(grow + (size_t)row * ld + 8 * chunk) = v; }
}
struct EpiProj {
    static constexpr int REPS = REP_E1; static constexpr bool PERM = true, AFTER_DRAIN = false;
    bf16_t* O; int ldc; bf16_t* QN; bf16_t* KN; const float* gq; const float* gk; float* out_k; float* out_v; PG8_LAS float* xch;
    __device__ __forceinline__ void operator()(const f32x4 (&acc)[2][2][4][2], const Unit& u, int wr, int wc, int fr, int fq, bool solo) const {
        const int row0 = u.pm * BM + wr * 64 + fr, col0 = u.pn * BM + wc * 32 + 8 * fq;
        PG8_LAS unsigned char* ldsb = (PG8_LAS unsigned char*)xch - 135168;
        const bool isq = u.pn >= 12 && u.pn < 16, isk = u.pn >= 16 && u.pn < 20, isv = u.pn >= 20;
        if (isq || isk) {
#pragma unroll
            for (int ai = 0; ai < 2; ++ai)
#pragma unroll
                for (int m = 0; m < 4; ++m)
#pragma unroll
                    for (int bj = 0; bj < 2; ++bj) { const f32x4 v0 = acc[ai][bj][m][0], v1 = acc[ai][bj][m][1];
                        float ss = ((v0[0] * v0[0] + v0[1] * v0[1]) + (v0[2] * v0[2] + v0[3] * v0[3])) + ((v1[0] * v1[0] + v1[1] * v1[1]) + (v1[2] * v1[2] + v1[3] * v1[3]));
                        ss += __shfl_xor(ss, 16); ss += __shfl_xor(ss, 32);
                        if (fq == 0) xch[((ai * HALF + wr * 64 + m * 16 + fr) * 2 + bj) * 4 + wc] = ss; }
        }
        asm volatile("s_waitcnt lgkmcnt(0)" ::: "memory"); __builtin_amdgcn_s_barrier(); asm volatile("" ::: "memory");
        if (isq || isk) {
            const float* g = isq ? gq : gk; const float gs = isq ? QSCALE : 1.0f; bf16_t* dst = isq ? QN : KN; const int hc0 = (u.pn - (isq ? 12 : 16)) * BM;
            f32x4 g0[2], g1[2];
#pragma unroll
            for (int bj = 0; bj < 2; ++bj) { g0[bj] = *(const f32x4*)(g + wc * 32 + 8 * fq) * gs; g1[bj] = *(const f32x4*)(g + wc * 32 + 8 * fq + 4) * gs; }
#pragma unroll
            for (int ai = 0; ai < 2; ++ai)
#pragma unroll
                for (int m = 0; m < 4; ++m) { const int r = row0 + ai * HALF + m * 16;
                    u32x4 w[2];
#pragma unroll
                    for (int bj = 0; bj < 2; ++bj) { const f32x4 p = *(const PG8_LAS f32x4*)(xch + ((ai * HALF + wr * 64 + m * 16 + fr) * 2 + bj) * 4);
                        const float rstd = 1.0f / sqrtf(((p[0] + p[1]) + (p[2] + p[3])) * (1.0f / 128.0f) + EPS);
                        const f32x4 v0 = acc[ai][bj][m][0] * rstd * g0[bj], v1 = acc[ai][bj][m][1] * rstd * g1[bj];
                        w[bj].x = cvt_pk_bf16(v0[0], v0[1]); w[bj].y = cvt_pk_bf16(v0[2], v0[3]); w[bj].z = cvt_pk_bf16(v1[0], v1[1]); w[bj].w = cvt_pk_bf16(v1[2], v1[3]); }
                    rg_store_bf16(ldsb + (((ai * 4 + m) & 1) ? EPI_BUF1 : EPI_BUF0), w[0], w[1], wr, wc, fr, fq, dst + (size_t)(r - fr) * 1024 + hc0, 1024); }
        } else {
#pragma unroll
            for (int ai = 0; ai < 2; ++ai)
#pragma unroll
                for (int m = 0; m < 4; ++m) { const int r = row0 + ai * HALF + m * 16;
                    u32x4 w[2];
#pragma unroll
                    for (int bj = 0; bj < 2; ++bj) { const f32x4 v0 = acc[ai][bj][m][0], v1 = acc[ai][bj][m][1];
                        w[bj].x = cvt_pk_bf16(v0[0], v0[1]); w[bj].y = cvt_pk_bf16(v0[2], v0[3]); w[bj].z = cvt_pk_bf16(v1[0], v1[1]); w[bj].w = cvt_pk_bf16(v1[2], v1[3]); }
                    rg_store_bf16(ldsb + (((ai * 4 + m) & 1) ? EPI_BUF1 : EPI_BUF0), w[0], w[1], wr, wc, fr, fq, O + (size_t)(r - fr) * ldc + u.pn * BM, (size_t)ldc); }
        }
    }
};
struct EpiRes1 {
    static constexpr int REPS = REP_E2; static constexpr bool PERM = false, AFTER_DRAIN = false;
    const float* xp; bf16_t* X1b; float* SSQ; PG8_LAS unsigned char* lds;
    __device__ __forceinline__ void operator()(const f32x4 (&acc)[2][2][4][2], const Unit& u, int wr, int wc, int fr, int fq, bool solo) const {
        const int row0 = u.pm * BM + wr * 64 + fr, col0 = u.pn * BM + wc * 32 + 4 * fq;
        if (solo) {
            asm volatile("s_waitcnt vmcnt(0)" ::: "memory"); __builtin_amdgcn_s_barrier(); asm volatile("" ::: "memory");
            const int lane = fr + 16 * fq;
#pragma unroll
            for (int ai = 0; ai < 2; ++ai) {
#pragma unroll
                for (int m = 0; m < 4; ++m)
#pragma unroll
                    for (int bj = 0; bj < 2; ++bj)
#pragma unroll
                        for (int i = 0; i < 2; ++i) { const int rr = 4 * wc + 2 * i + (lane >> 5), chunk = (lane & 31) ^ (rr & 15);
                            __builtin_amdgcn_global_load_lds((const unsigned*)(xp + (size_t)(u.pm * BM + ai * HALF + wr * 64 + m * 16 + rr) * DM + u.pn * BM + bj * HALF + 4 * chunk),
                                                             (PG8_LAS unsigned*)(lds + (m * 2 + bj) * 16384 + wr * 8192 + (4 * wc + 2 * i) * 512), 16, 0, 0); }
                asm volatile("s_waitcnt vmcnt(0)" ::: "memory"); __builtin_amdgcn_s_barrier(); asm volatile("" ::: "memory");
#pragma unroll
                for (int m = 0; m < 4; ++m) { const int r = row0 + ai * HALF + m * 16; const size_t off = (size_t)r * DM + col0;
                    float ss = 0.f;
#pragma unroll
                    for (int bj = 0; bj < 2; ++bj)
#pragma unroll
                        for (int n = 0; n < 2; ++n) { const f32x4 xv = *(const PG8_LAS f32x4*)(lds + (m * 2 + bj) * 16384 + wr * 8192 + fr * 512 + 16 * ((8 * wc + 4 * n + fq) ^ fr));
                            const f32x4 o = xv + acc[ai][bj][m][n];
                            ss += (o[0] * o[0] + o[1] * o[1]) + (o[2] * o[2] + o[3] * o[3]);
                            u32x2 pk; pk.x = cvt_pk_bf16(o[0], o[1]); pk.y = cvt_pk_bf16(o[2], o[3]);
                            *(u32x2*)(X1b + off + bj * HALF + n * 16) = pk; }
                    ss += __shfl_xor(ss, 16); ss += __shfl_xor(ss, 32);
                    if (fq == 0) SSQ[(size_t)r * 32 + u.pn * 4 + wc] = ss; }
                asm volatile("s_waitcnt lgkmcnt(0)" ::: "memory"); __builtin_amdgcn_s_barrier(); asm volatile("" ::: "memory");
            }
            return;
        }
#pragma unroll
        for (int ai = 0; ai < 2; ++ai) {
            f32x4 xv[4][2][2];
#pragma unroll
            for (int m = 0; m < 4; ++m)
#pragma unroll
                for (int bj = 0; bj < 2; ++bj)
#pragma unroll
                    for (int n = 0; n < 2; ++n) xv[m][bj][n] = __builtin_nontemporal_load((const f32x4*)(xp + (size_t)(row0 + ai * HALF + m * 16) * DM + col0 + bj * HALF + n * 16));
            asm volatile("" ::: "memory");
#pragma unroll
            for (int m = 0; m < 4; ++m) { const int r = row0 + ai * HALF + m * 16; const size_t off = (size_t)r * DM + col0;
                float ss = 0.f;
#pragma unroll
                for (int bj = 0; bj < 2; ++bj)
#pragma unroll
                    for (int n = 0; n < 2; ++n) { const f32x4 o = xv[m][bj][n] + acc[ai][bj][m][n];
                        ss += (o[0] * o[0] + o[1] * o[1]) + (o[2] * o[2] + o[3] * o[3]);
                        u32x2 pk; pk.x = cvt_pk_bf16(o[0], o[1]); pk.y = cvt_pk_bf16(o[2], o[3]);
                        *(u32x2*)(X1b + off + bj * HALF + n * 16) = pk; }
                ss += __shfl_xor(ss, 16); ss += __shfl_xor(ss, 32);
                if (fq == 0) SSQ[(size_t)r * 32 + u.pn * 4 + wc] = ss; }
        }
    }
};
struct EpiSwiGLU {
    static constexpr int REPS = REP_E3; static constexpr bool PERM = false, AFTER_DRAIN = false;
    const float* SSQ; bf16_t* H;
    __device__ __forceinline__ void operator()(const f32x4 (&acc)[2][2][4][2], const Unit& u, int wr, int wc, int fr, int fq, bool solo) const {
        const int row0 = u.pm * BM + wr * 64 + fr, col0 = u.pn * HALF + wc * 32 + 8 * fq;
#pragma unroll
        for (int ai = 0; ai < 2; ++ai)
#pragma unroll
            for (int m = 0; m < 4; ++m) { const int r = row0 + ai * HALF + m * 16;
                const f32x4* sp = (const f32x4*)(SSQ + (size_t)r * 32 + fq * 8); const f32x4 a = sp[0], b = sp[1];
                float s = ((a[0] + a[1]) + (a[2] + a[3])) + ((b[0] + b[1]) + (b[2] + b[3]));
                s += __shfl_xor(s, 16); s += __shfl_xor(s, 32);
                const float rstd = __builtin_amdgcn_rsqf(s * (1.0f / DM) + EPS);
                float hv[8];
#pragma unroll
                for (int n = 0; n < 2; ++n)
#pragma unroll
                    for (int j = 0; j < 4; ++j) { const float gt = acc[ai][0][m][n][j] * rstd, up = acc[ai][1][m][n][j] * rstd;
                        hv[n * 4 + j] = gt * up * __builtin_amdgcn_rcpf(1.0f + __expf(-gt)); }
                u32x4 w; w.x = cvt_pk_bf16(hv[0], hv[1]); w.y = cvt_pk_bf16(hv[2], hv[3]); w.z = cvt_pk_bf16(hv[4], hv[5]); w.w = cvt_pk_bf16(hv[6], hv[7]);
                *(u32x4*)(H + (size_t)r * DFF + col0) = w; }
    }
};
struct EpiOut {
    static constexpr int REPS = REP_E4; static constexpr bool PERM = false, AFTER_DRAIN = false;
    const bf16_t* X1b; float* out; PG8_LAS unsigned char* lds;
    __device__ __forceinline__ void operator()(const f32x4 (&acc)[2][2][4][2], const Unit& u, int wr, int wc, int fr, int fq, bool solo) const {
        const int row0 = u.pm * BM + wr * 64 + fr, col0 = u.pn * BM + wc * 32 + 4 * fq;
        if (solo) {
            asm volatile("s_waitcnt vmcnt(0)" ::: "memory"); __builtin_amdgcn_s_barrier(); asm volatile("" ::: "memory");
            const int lane = fr + 16 * fq;
#pragma unroll
            for (int ai = 0; ai < 2; ++ai)
#pragma unroll
                for (int m = 0; m < 4; ++m)
#pragma unroll
                    for (int i = 0; i < 2; ++i) { const int rr = 4 * wc + 2 * i + (lane >> 5), chunk = (lane & 31) ^ (rr & 15);
                        __builtin_amdgcn_global_load_lds((const unsigned*)(X1b + (size_t)(u.pm * BM + ai * HALF + wr * 64 + m * 16 + rr) * DM + u.pn * BM + 8 * chunk),
                                                         (PG8_LAS unsigned*)(lds + (ai * 4 + m) * 16384 + wr * 8192 + (4 * wc + 2 * i) * 512), 16, 0, 0); }
            asm volatile("s_waitcnt vmcnt(0)" ::: "memory"); __builtin_amdgcn_s_barrier(); asm volatile("" ::: "memory");
#pragma unroll
            for (int ai = 0; ai < 2; ++ai)
#pragma unroll
                for (int m = 0; m < 4; ++m) { const size_t off = (size_t)(row0 + ai * HALF + m * 16) * DM + col0;
#pragma unroll
                    for (int bj = 0; bj < 2; ++bj)
#pragma unroll
                        for (int n = 0; n < 2; ++n) { const u32x2 w = *(const PG8_LAS u32x2*)(lds + (ai * 4 + m) * 16384 + wr * 8192 + fr * 512 + 16 * ((16 * bj + 4 * wc + 2 * n + (fq >> 1)) ^ fr) + 8 * (fq & 1));
                            const f32x4 xv = (f32x4){__builtin_bit_cast(float, w.x << 16), __builtin_bit_cast(float, w.x & 0xffff0000u), __builtin_bit_cast(float, w.y << 16), __builtin_bit_cast(float, w.y & 0xffff0000u)};
                            __builtin_nontemporal_store(xv + acc[ai][bj][m][n], (f32x4*)(out + off + bj * HALF + n * 16)); } }
            return;
        }
        u32x2 xw[2][4][2][2];
#pragma unroll
        for (int ai = 0; ai < 2; ++ai)
#pragma unroll
            for (int m = 0; m < 4; ++m)
#pragma unroll
                for (int bj = 0; bj < 2; ++bj)
#pragma unroll
                    for (int n = 0; n < 2; ++n) xw[ai][m][bj][n] = *(const u32x2*)(X1b + (size_t)(row0 + ai * HALF + m * 16) * DM + col0 + bj * HALF + n * 16);
        asm volatile("" ::: "memory");
#pragma unroll
        for (int ai = 0; ai < 2; ++ai)
#pragma unroll
            for (int m = 0; m < 4; ++m) { const size_t off = (size_t)(row0 + ai * HALF + m * 16) * DM + col0;
#pragma unroll
                for (int bj = 0; bj < 2; ++bj)
#pragma unroll
                    for (int n = 0; n < 2; ++n) { const u32x2 w = xw[ai][m][bj][n];
                        const f32x4 xv = (f32x4){__builtin_bit_cast(float, w.x << 16), __builtin_bit_cast(float, w.x & 0xffff0000u), __builtin_bit_cast(float, w.y << 16), __builtin_bit_cast(float, w.y & 0xffff0000u)};
                        __builtin_nontemporal_store(xv + acc[ai][bj][m][n], (f32x4*)(out + off + bj * HALF + n * 16)); } }
    }
};

template <class Epi, class Sched, bool ALIGN_EPI = false, bool SP2 = false>
__device__ __forceinline__ void gemm_phase(PG8_LAS unsigned char* lds, const Gemm g, const Sched& S, const Epi& E) {
    int tid_ = threadIdx.x; asm volatile("" : "+v"(tid_));
    const int tid = tid_, wid = __builtin_amdgcn_readfirstlane(tid >> 6), lane = tid & 63, wr = wid >> 2, wc = wid & 3, fr = lane & 15, fq = lane >> 4;
    const int K = g.K, nt = K / BK;
    unsigned voffA[2], voffB[2];
#pragma unroll
    for (int i = 0; i < 2; ++i) { int R, C; stage_rc(tid * 16 + i * 8192, R, C); const int Rb = Epi::PERM ? ((R & ~31) + perm32(R & 31)) : R;
        voffA[i] = (unsigned)(R * K + C) * 2u; voffB[i] = (unsigned)(Rb * K + C) * 2u; }
    const size_t kstep = (size_t)(BK * 2);
    const size_t hstep = (size_t)HALF * K * 2;
    const size_t tstep = 2 * hstep;
    const unsigned ldsw = (unsigned)wid * 1024u;
    const int aoff = lds_byte(wr * 64 + fr, fq * 8), boff = lds_byte(wc * 32 + fr, fq * 8);
#define PG8_SA(b, h) (((b) * 2 + (h)) * HTB)
#define PG8_SB(b, h) ((4 + (b) * 2 + (h)) * HTB)
#define PG8_STAGE(bufoff, gbase, voff) do { _Pragma("unroll") for (int _i = 0; _i < 2; ++_i) \
        __builtin_amdgcn_global_load_lds((const unsigned*)((const char*)(gbase) + (voff)[_i]), (PG8_LAS unsigned*)(lds + (bufoff) + ldsw + _i * 8192), 16, 0, 0); } while (0)
#define PG8_LDA(dst, b, h) do { _Pragma("unroll") for (int m = 0; m < 4; ++m) _Pragma("unroll") for (int k = 0; k < 2; ++k) dst[m][k] = *(const PG8_LAS bf16x8*)(lds + PG8_SA(b, h) + aoff + m * 2048 + k * 1024); } while (0)
#define PG8_LDB(dst, b, h) do { _Pragma("unroll") for (int n = 0; n < 2; ++n) _Pragma("unroll") for (int k = 0; k < 2; ++k) dst[n][k] = *(const PG8_LAS bf16x8*)(lds + PG8_SB(b, h) + boff + n * 2048 + k * 1024); } while (0)
#define PG8_MMA(ai, bj, At, Bt) do { __builtin_amdgcn_s_setprio(1); _Pragma("unroll") for (int m = 0; m < 4; ++m) _Pragma("unroll") for (int n = 0; n < 2; ++n) _Pragma("unroll") for (int k = 0; k < 2; ++k) \
        acc[ai][bj][m][n] = __builtin_amdgcn_mfma_f32_16x16x32_bf16(Bt[n][k], At[m][k], acc[ai][bj][m][n], 0, 0, 0); __builtin_amdgcn_s_setprio(0); } while (0)
#define PG8_WAIT_V(n) asm volatile("s_waitcnt vmcnt(" #n ")" ::: "memory")
#define PG8_WAIT_L(n) asm volatile("s_waitcnt lgkmcnt(" #n ")" ::: "memory")
#define PG8_BAR __builtin_amdgcn_s_barrier()
#define PG8_SCHED __builtin_amdgcn_sched_barrier(0)
    Unit cur, nxt; int ui = 0;
    if (!S.next(0, cur)) return;
    f32x4 acc[2][2][4][2];
#pragma unroll
    for (int a = 0; a < 2; ++a)
#pragma unroll
        for (int b = 0; b < 2; ++b)
#pragma unroll
            for (int m = 0; m < 4; ++m)
#pragma unroll
                for (int n = 0; n < 2; ++n) acc[a][b][m][n] = (f32x4){0.f, 0.f, 0.f, 0.f};
    bf16x8 At[4][2], B0[2][2], B1[2][2];
    const char* cA = (const char*)g.A + (size_t)cur.pm * tstep; const char* cB = (const char*)g.Bt + (size_t)cur.pn * tstep;
    S.a_ready(cur);
    if constexpr (SP2) {
        PG8_STAGE(PG8_SB(0, 0), cB, voffB); PG8_STAGE(PG8_SB(0, 1), cB + hstep, voffB); PG8_STAGE(PG8_SA(0, 0), cA, voffA); PG8_STAGE(PG8_SA(0, 1), cA + hstep, voffA);
        if (wr == 1) PG8_BAR;
        PG8_WAIT_V(2); PG8_BAR;
        PG8_STAGE(PG8_SB(1, 0), cB + kstep, voffB); PG8_STAGE(PG8_SA(1, 0), cA + kstep, voffA); PG8_STAGE(PG8_SB(1, 1), cB + hstep + kstep, voffB);
        PG8_WAIT_V(6); PG8_BAR;
    } else {
        PG8_STAGE(PG8_SB(0, 0), cB, voffB); PG8_STAGE(PG8_SA(0, 0), cA, voffA); PG8_STAGE(PG8_SB(0, 1), cB + hstep, voffB); PG8_STAGE(PG8_SA(0, 1), cA + hstep, voffA);
        if (wr == 1) PG8_BAR;
        PG8_WAIT_V(4); PG8_BAR;
        PG8_STAGE(PG8_SB(1, 0), cB + kstep, voffB); PG8_STAGE(PG8_SA(1, 0), cA + kstep, voffA); PG8_STAGE(PG8_SB(1, 1), cB + hstep + kstep, voffB);
        PG8_WAIT_V(6); PG8_BAR;
    }
    for (;;) {
        const bool has_next = S.next(ui + 1, nxt);
        const char* nA = has_next ? (const char*)g.A + (size_t)nxt.pm * tstep : cA; const char* nB = has_next ? (const char*)g.Bt + (size_t)nxt.pn * tstep : cB;
        for (int t = 0; t < nt; t += 2) {
            const bool last = (t == nt - 2);
            const char* a1 = cA + (size_t)(t + 1) * kstep;
            const char* a2 = last ? nA : cA + (size_t)(t + 2) * kstep; const char* b2 = last ? nB : cB + (size_t)(t + 2) * kstep;
            const char* a3 = a2 + kstep; const char* b3 = b2 + kstep;
            if (last && has_next) S.a_ready(nxt);
            if constexpr (SP2) {
            PG8_LDB(B0, 0, 0); PG8_LDB(B1, 0, 1); PG8_SCHED; PG8_LDA(At, 0, 0); PG8_STAGE(PG8_SA(1, 1), a1 + hstep, voffA);
            PG8_WAIT_V(8); PG8_WAIT_L(0); PG8_BAR; PG8_MMA(0, 0, At, B0); PG8_MMA(0, 1, At, B1); PG8_BAR; PG8_SCHED;
            PG8_LDA(At, 0, 1); PG8_STAGE(PG8_SB(0, 0), b2, voffB); PG8_STAGE(PG8_SB(0, 1), b2 + hstep, voffB); PG8_STAGE(PG8_SA(0, 0), a2, voffA);
            PG8_WAIT_V(8); PG8_WAIT_L(0); PG8_BAR; PG8_MMA(1, 0, At, B0); PG8_MMA(1, 1, At, B1); PG8_BAR; PG8_SCHED;
            PG8_LDB(B0, 1, 0); PG8_LDB(B1, 1, 1); PG8_SCHED; PG8_LDA(At, 1, 0); PG8_STAGE(PG8_SA(0, 1), a2 + hstep, voffA);
            PG8_WAIT_V(8); PG8_WAIT_L(0); PG8_BAR; PG8_MMA(0, 0, At, B0); PG8_MMA(0, 1, At, B1); PG8_BAR; PG8_SCHED;
            PG8_LDA(At, 1, 1); PG8_STAGE(PG8_SB(1, 0), b3, voffB); PG8_STAGE(PG8_SB(1, 1), b3 + hstep, voffB); PG8_STAGE(PG8_SA(1, 0), a3, voffA);
            PG8_WAIT_V(8); PG8_WAIT_L(0); PG8_BAR; PG8_MMA(1, 0, At, B0); PG8_MMA(1, 1, At, B1); PG8_BAR; PG8_SCHED;
            } else {
            PG8_LDB(B0, 0, 0); PG8_SCHED; PG8_LDA(At, 0, 0); PG8_STAGE(PG8_SA(1, 1), a1 + hstep, voffA);
            PG8_WAIT_L(8); PG8_BAR; PG8_WAIT_L(0); PG8_MMA(0, 0, At, B0); PG8_BAR; PG8_SCHED;
            PG8_LDB(B1, 0, 1); PG8_STAGE(PG8_SB(0, 0), b2, voffB);
            PG8_BAR; PG8_WAIT_L(0); PG8_MMA(0, 1, At, B1); PG8_BAR;
            PG8_LDA(At, 0, 1); PG8_STAGE(PG8_SA(0, 0), a2, voffA);
            PG8_BAR; PG8_WAIT_L(0); PG8_MMA(1, 0, At, B0); PG8_BAR; PG8_SCHED;
            PG8_STAGE(PG8_SB(0, 1), b2 + hstep, voffB);
            PG8_WAIT_V(6); PG8_BAR; PG8_MMA(1, 1, At, B1); PG8_BAR;
            PG8_LDB(B0, 1, 0); PG8_SCHED; PG8_LDA(At, 1, 0); PG8_STAGE(PG8_SA(0, 1), a2 + hstep, voffA);
            PG8_WAIT_L(8); PG8_BAR; PG8_WAIT_L(0); PG8_MMA(0, 0, At, B0); PG8_BAR; PG8_SCHED;
            PG8_LDB(B1, 1, 1); PG8_STAGE(PG8_SB(1, 0), b3, voffB);
            PG8_BAR; PG8_WAIT_L(0); PG8_MMA(0, 1, At, B1); PG8_BAR;
            PG8_LDA(At, 1, 1); PG8_STAGE(PG8_SA(1, 0), a3, voffA);
            PG8_BAR; PG8_WAIT_L(0); PG8_MMA(1, 0, At, B0); PG8_BAR; PG8_SCHED;
            PG8_STAGE(PG8_SB(1, 1), b3 + hstep, voffB);
            PG8_WAIT_V(6); PG8_BAR; PG8_MMA(1, 1, At, B1); PG8_BAR;
            }
        }
        if constexpr (ALIGN_EPI) { if (wr == 0) PG8_BAR; }
        if constexpr (!Epi::AFTER_DRAIN) { const bool solo = (ui == 0) && !has_next;
            E(acc, cur, wr, wc, fr, fq, solo); if constexpr (Epi::REPS > 1) { asm volatile("" ::: "memory"); Unit c2 = cur; int fr2 = fr, fq2 = fq; asm volatile("" : "+s"(c2.pm), "+s"(c2.pn), "+v"(fr2), "+v"(fq2)); E(acc, c2, wr, wc, fr2, fq2, solo); } S.done(cur); }
        if (!has_next) break;
#pragma unroll
        for (int a = 0; a < 2; ++a)
#pragma unroll
            for (int b = 0; b < 2; ++b)
#pragma unroll
                for (int m = 0; m < 4; ++m)
#pragma unroll
                    for (int n = 0; n < 2; ++n) acc[a][b][m][n] = (f32x4){0.f, 0.f, 0.f, 0.f};
        cur = nxt; cA = nA; cB = nB; ++ui;
        if constexpr (ALIGN_EPI) { if (wr == 1) PG8_BAR; }
    }
    PG8_WAIT_V(0);
    if constexpr (!ALIGN_EPI) { if (wr == 0) PG8_BAR; }
    PG8_BAR;
#undef PG8_SA
#undef PG8_SB
#undef PG8_STAGE
#undef PG8_LDA
#undef PG8_LDB
#undef PG8_MMA
#undef PG8_WAIT_V
#undef PG8_WAIT_L
#undef PG8_BAR
#undef PG8_SCHED
}
}

#define GAS __attribute__((address_space(1)))
#define LAS __attribute__((address_space(3)))
typedef unsigned short bf16;
typedef unsigned v4u __attribute__((ext_vector_type(4)));
typedef unsigned v2u __attribute__((ext_vector_type(2)));
typedef float f32x4 __attribute__((ext_vector_type(4)));
typedef float f32x2 __attribute__((ext_vector_type(2)));
#define LDS_WAIT() asm volatile("s_waitcnt lgkmcnt(0)" ::: "memory")
constexpr int NWAVES = 8, NTHR = 512;
constexpr int LDS_BYTES = 160 * 1024;
constexpr int LDS_ST_OFF = LDS_BYTES - 64;

__device__ __forceinline__ int opaque_tid() { int t = threadIdx.x; asm volatile("" : "+v"(t)); return t; }
__device__ __forceinline__ unsigned f2bf(float f) { unsigned u = __builtin_bit_cast(unsigned, f); return (u + 0x7fffu + ((u >> 16) & 1u)) >> 16; }
__device__ __forceinline__ unsigned pk2(float lo, float hi) { unsigned r; asm volatile("v_cvt_pk_bf16_f32 %0, %1, %2" : "=v"(r) : "v"(lo), "v"(hi)); return r; }
__device__ __forceinline__ float bf_lo(unsigned w) { return __builtin_bit_cast(float, w << 16); }
__device__ __forceinline__ float bf_hi(unsigned w) { return __builtin_bit_cast(float, w & 0xffff0000u); }
__device__ __forceinline__ float wave_sum(float v) {
#pragma unroll
    for (int o = 1; o < 64; o <<= 1) v += __shfl_xor(v, o);
    return v;
}
__device__ __forceinline__ float wave_max(float v) {
#pragma unroll
    for (int o = 1; o < 64; o <<= 1) v = fmaxf(v, __shfl_xor(v, o));
    return v;
}

constexpr size_t MiB = 1u << 20;
constexpr size_t WS_CTL = 0;
constexpr size_t WS_WIN = 1 * MiB;
constexpr size_t WS_WOUT = 25 * MiB;
constexpr size_t WS_WGU = 33 * MiB;
constexpr size_t WS_WDN = 77 * MiB;
constexpr size_t WS_XN = 99 * MiB;
constexpr size_t WS_PROJ = 132 * MiB;
constexpr size_t WS_QN = 231 * MiB;
constexpr size_t WS_KN = 248 * MiB;
constexpr size_t WS_VT1 = 265 * MiB, WS_VT2 = 281 * MiB, WS_VT3 = 297 * MiB;
constexpr size_t WS_MIX = 313 * MiB;
constexpr size_t WS_X1 = 346 * MiB;
constexpr size_t WS_XN2 = 412 * MiB;
constexpr size_t WS_SSQ = 445 * MiB;
constexpr size_t WS_H = 447 * MiB;
constexpr size_t WS_END = 538 * MiB;

constexpr size_t O_Y = 0;
constexpr size_t O_PK = (size_t)MT * DM;
constexpr size_t O_PV = O_PK + (size_t)2048 * 1024;
constexpr size_t O_PC = O_PV + (size_t)2048 * 1024;
constexpr size_t O_SK = O_PC + 2048;
constexpr size_t O_SV = O_SK + (size_t)NSAMP * 1024;
constexpr size_t O_SC = O_SV + (size_t)NSAMP * 1024;
constexpr size_t O_END = O_SC + (size_t)DBATCH * 2 * 1024;

struct Args {
    const float* x_prompt; const float* x_sample; const float* cache_k; const float* cache_v; const float* state_conv; const float* norm_mix; const float* w_in; const float* conv_w;
    const float* q_norm; const float* k_norm; const float* rel_bias; const float* w_out; const float* norm_ffn; const float* w_gate; const float* w_up; const float* w_down;
    float* out; unsigned char* ws;
};

__device__ __forceinline__ void p0_transpose_item(const float* W, int N, int K, int c0, int k0, bf16* WT, int drow0, bool perm, LAS float* scr, int lane, const float* kscale = nullptr) {
    const int ksub = lane >> 4, n4 = lane & 15;
    f32x4 v[16];
    const GAS f32x4* src = (const GAS f32x4*)(W + (size_t)(k0 + ksub) * N + c0 + 4 * n4);
#pragma unroll
    for (int i = 0; i < 16; ++i) v[i] = __builtin_nontemporal_load(src + (size_t)i * N);
    if (kscale) {
#pragma unroll
        for (int i = 0; i < 16; ++i) v[i] = v[i] * kscale[k0 + 4 * i + ksub]; }
#pragma unroll
    for (int i = 0; i < 16; ++i) { LAS float* d = scr + (4 * i + ksub) * 65 + 4 * n4; d[0] = v[i][0]; d[1] = v[i][1]; d[2] = v[i][2]; d[3] = v[i][3]; }
    LDS_WAIT(); asm volatile("" ::: "memory");
    const int c = lane >> 3, nsub = lane & 7;
#pragma unroll
    for (int j = 0; j < 8; ++j) { const int n = nsub + 8 * j; const int ns = perm ? ((n & 32) + pg8::perm32(n & 31)) : n; const LAS float* s = scr + (8 * c) * 65 + ns;
        v4u o; o.x = pk2(s[0 * 65], s[1 * 65]); o.y = pk2(s[2 * 65], s[3 * 65]); o.z = pk2(s[4 * 65], s[5 * 65]); o.w = pk2(s[6 * 65], s[7 * 65]);
        *(GAS v4u*)(WT + (size_t)(drow0 + n) * K + k0 + 8 * c) = o; }
    LDS_WAIT(); asm volatile("" ::: "memory");
}
__device__ __forceinline__ void p0_rms_row(const float* xrow, const float* g, bf16* orow, int lane) {
    const GAS f32x4* xr = (const GAS f32x4*)xrow + lane; const GAS f32x4* gr = (const GAS f32x4*)g + lane;
    f32x4 v[8]; float s = 0.f;
#pragma unroll
    for (int j = 0; j < 8; ++j) { v[j] = __builtin_nontemporal_load(xr + 64 * j); s += (v[j].x * v[j].x + v[j].y * v[j].y) + (v[j].z * v[j].z + v[j].w * v[j].w); }
    const float rstd = 1.0f / sqrtf(wave_sum(s) * (1.f / DM) + EPS);
    GAS v2u* o8 = (GAS v2u*)orow + lane;
#pragma unroll
    for (int j = 0; j < 8; ++j) { const f32x4 gg = gr[64 * j]; v2u o; o.x = pk2(v[j].x * rstd * gg.x, v[j].y * rstd * gg.y); o.y = pk2(v[j].z * rstd * gg.z, v[j].w * rstd * gg.w); o8[64 * j] = o; }
}
__device__ __forceinline__ void phase_prologue(const Args& A, LAS unsigned char* lds, int vcu, int G) {
    const int tid = opaque_tid(), lane = tid & 63, wave = __builtin_amdgcn_readfirstlane(tid >> 6);
    LAS float* scr = (LAS float*)(lds + wave * 17408);
    const int gw = vcu * NWAVES + wave, NGW = G * NWAVES;
    bf16* WIN = (bf16*)(A.ws + WS_WIN); bf16* WOUT = (bf16*)(A.ws + WS_WOUT); bf16* WGU = (bf16*)(A.ws + WS_WGU); bf16* WDN = (bf16*)(A.ws + WS_WDN); bf16* XN = (bf16*)(A.ws + WS_XN);
    constexpr int I_IN = (DM / 64) * (DIN / 64), I_OUT = (DM / 64) * (DM / 64), I_GU = (DM / 64) * (NGU / 64), I_DN = (DFF / 64) * (DM / 64);
    constexpr int NITEMS = I_IN;
    for (int it = gw; it < NITEMS; it += NGW) { const int nb = it % (DIN / 64), kb = it / (DIN / 64); p0_transpose_item(A.w_in, DIN, DM, 64 * nb, 64 * kb, WIN, 64 * nb, false, scr, lane); }
    for (int m = gw; m < MT; m += NGW) p0_rms_row(m < SEQ ? A.x_prompt + (size_t)m * DM : A.x_sample + (size_t)(m - SEQ) * DM, A.norm_mix, XN + (size_t)m * DM, lane);
}
constexpr int PL_WO = (DM / 64) * (DM / 64) / 8, PL_GU = PL_WO + (DM / 64) * (NGU / 64) / 8;
__device__ __forceinline__ void convert_gu_item(const Args& A, LAS unsigned char* lds, int item) {
    const int tid = opaque_tid(), lane = tid & 63, wave = __builtin_amdgcn_readfirstlane(tid >> 6);
    LAS float* scr = (LAS float*)(lds + wave * 17408);
    bf16* WGU = (bf16*)(A.ws + WS_WGU);
    if (item < PL_WO) { const int r = item * 8 + wave; const int nb = r % (DM / 64), kb = r / (DM / 64); p0_transpose_item(A.w_out, DM, DM, 64 * nb, 64 * kb, (bf16*)(A.ws + WS_WOUT), 64 * nb, false, scr, lane); return; }
    item -= PL_WO;
    { const int r = item * 8 + wave; const int nb = r % (NGU / 64), kb = r / (NGU / 64);
        const int pn = nb >> 2, t = (nb >> 1) & 1, w2 = nb & 1; p0_transpose_item(t ? A.w_up : A.w_gate, DFF, DM, 128 * pn + 64 * w2, 64 * kb, WGU, 64 * nb, true, scr, lane, A.norm_ffn); }
}
__device__ __forceinline__ void convert_wdown(const Args& A, LAS unsigned char* lds, int widx, int nw) {
    const int tid = opaque_tid(), lane = tid & 63, wave = __builtin_amdgcn_readfirstlane(tid >> 6);
    LAS float* scr = (LAS float*)(lds + wave * 17408);
    bf16* WDN = (bf16*)(A.ws + WS_WDN);
    constexpr int I_DN = (DFF / 64) * (DM / 64);
    for (int r = widx * NWAVES + wave; r < I_DN; r += nw * NWAVES) { const int nb = r % (DM / 64), kb = r / (DM / 64); p0_transpose_item(A.w_down, DM, DFF, 64 * nb, 64 * kb, WDN, 64 * nb, false, scr, lane); }
}

__device__ __forceinline__ void unpack8(const v4u w, float* f) { f[0] = bf_lo(w.x); f[1] = bf_hi(w.x); f[2] = bf_lo(w.y); f[3] = bf_hi(w.y); f[4] = bf_lo(w.z); f[5] = bf_hi(w.z); f[6] = bf_lo(w.w); f[7] = bf_hi(w.w); }
__device__ __forceinline__ float softmax_bound_l2(const Args& A, int lane) {
    float mq = fmaxf(fabsf(A.q_norm[lane]), fabsf(A.q_norm[lane + 64])), mk = fmaxf(fabsf(A.k_norm[lane]), fabsf(A.k_norm[lane + 64]));
    float mb = fmaxf(fmaxf(fabsf(A.rel_bias[lane]), fabsf(A.rel_bias[lane + 64])), fmaxf(fabsf(A.rel_bias[lane + 128]), fabsf(A.rel_bias[lane + 192])));
    mq = wave_max(mq); mk = wave_max(mk); mb = wave_max(mb);
    return LOG2E * (11.313708498984761f * mq * mk * 1.01f + mb);
}
typedef short bf16x8 __attribute__((ext_vector_type(8)));
__device__ __forceinline__ bf16x8 ld16(const bf16* p) { return __builtin_bit_cast(bf16x8, *(const GAS v4u*)p); }
typedef short s16x4 __attribute__((ext_vector_type(4)));
constexpr int AT_STAGE = 65536, AT_VOFF = 32768, AT_TBL = 131072;
__device__ __forceinline__ int swz_f(int row) { return (((row ^ (row >> 2) ^ (row >> 4)) & 1) << 1) | ((((row >> 1) ^ (row >> 5)) & 1) << 2) | ((((row >> 3) ^ (row >> 6)) & 1) << 3); }
__device__ __forceinline__ void attn2_stage(LAS unsigned char* lds, int buf, const bf16* Kg, const bf16* Vg, int P0, int wave, int lane) {
#pragma unroll
    for (int i = 0; i < 4; ++i) { const int row = (wave * 4 + i) * 4 + (lane >> 4), c = (lane & 15) ^ swz_f(row);
        __builtin_amdgcn_global_load_lds((const unsigned*)(Kg + (size_t)(P0 + row) * 1024 + 8 * c), (LAS unsigned*)(lds + buf * AT_STAGE + (wave * 4 + i) * 1024), 16, 0, 0); }
#pragma unroll
    for (int i = 0; i < 4; ++i) { const int row = (wave * 4 + i) * 4 + (lane >> 4), c = (lane & 15) ^ swz_f(row);
        __builtin_amdgcn_global_load_lds((const unsigned*)(Vg + (size_t)(P0 + row) * DIN + 8 * c), (LAS unsigned*)(lds + buf * AT_STAGE + AT_VOFF + (wave * 4 + i) * 1024), 16, 0, 0); }
}
template <bool HALF, int CX, int OFF>
__device__ __forceinline__ void attn5_block(const LAS unsigned char* Kb, const LAS unsigned char* Vb, unsigned ko0, unsigned ko1, unsigned voA, unsigned voB, const bf16x8 (&qf)[4], f32x4 (&o)[8], float& lsum, const LAS float* tj) {
    f32x4 s0 = (f32x4){tj[0], tj[-1], tj[-2], tj[-3]}, s1 = HALF ? (f32x4){0.f, 0.f, 0.f, 0.f} : (f32x4){tj[-4], tj[-5], tj[-6], tj[-7]};
    {   bf16x8 kf0[4];
#pragma unroll
        for (int ks = 0; ks < 4; ++ks) kf0[ks] = *(const LAS bf16x8*)(Kb + (ko0 ^ (unsigned)(64 * ks ^ CX)) + OFF);
        if (!HALF) { bf16x8 kf1[4];
#pragma unroll
            for (int ks = 0; ks < 4; ++ks) kf1[ks] = *(const LAS bf16x8*)(Kb + (ko1 ^ (unsigned)(64 * ks ^ CX)) + OFF);
#pragma unroll
            for (int ks = 0; ks < 4; ++ks) { s0 = __builtin_amdgcn_mfma_f32_16x16x32_bf16(kf0[ks], qf[ks], s0, 0, 0, 0); s1 = __builtin_amdgcn_mfma_f32_16x16x32_bf16(kf1[ks], qf[ks], s1, 0, 0, 0); }
        } else {
#pragma unroll
            for (int ks = 0; ks < 4; ++ks) s0 = __builtin_amdgcn_mfma_f32_16x16x32_bf16(kf0[ks], qf[ks], s0, 0, 0, 0);
        }
    }
    float pv[8];
#pragma unroll
    for (int e = 0; e < (HALF ? 4 : 8); ++e) { const float sv = e < 4 ? s0[e] : s1[e - 4]; pv[e] = __builtin_amdgcn_exp2f(sv); lsum += pv[e]; }
    v4u pw; pw.x = pg8::cvt_pk_bf16(pv[0], pv[1]); pw.y = pg8::cvt_pk_bf16(pv[2], pv[3]);
    if (HALF) { pw.z = 0u; pw.w = 0u; } else { pw.z = pg8::cvt_pk_bf16(pv[4], pv[5]); pw.w = pg8::cvt_pk_bf16(pv[6], pv[7]); }
    const bf16x8 pf = __builtin_bit_cast(bf16x8, pw);
    const unsigned vA = (unsigned)(size_t)Vb + voA, vB = (unsigned)(size_t)Vb + voB;
    s16x4 va[8], vb[8];
#pragma unroll
    for (int dt = 0; dt < 8; ++dt) {
        asm volatile("ds_read_b64_tr_b16 %0, %1 offset:%2" : "=v"(va[dt]) : "v"(vA ^ (unsigned)(32 * dt ^ CX)), "i"(OFF));
        if (!HALF) asm volatile("ds_read_b64_tr_b16 %0, %1 offset:%2" : "=v"(vb[dt]) : "v"(vB ^ (unsigned)(32 * dt ^ CX)), "i"(OFF));
        else vb[dt] = (s16x4){0, 0, 0, 0};
    }
    if (!HALF) asm volatile("s_waitcnt lgkmcnt(0)" : "+v"(va[0]), "+v"(va[1]), "+v"(va[2]), "+v"(va[3]), "+v"(va[4]), "+v"(va[5]), "+v"(va[6]), "+v"(va[7]), "+v"(vb[0]), "+v"(vb[1]), "+v"(vb[2]), "+v"(vb[3]), "+v"(vb[4]), "+v"(vb[5]), "+v"(vb[6]), "+v"(vb[7]) :: "memory");
    else asm volatile("s_waitcnt lgkmcnt(0)" : "+v"(va[0]), "+v"(va[1]), "+v"(va[2]), "+v"(va[3]), "+v"(va[4]), "+v"(va[5]), "+v"(va[6]), "+v"(va[7]) :: "memory");
    __builtin_amdgcn_sched_barrier(0);
#pragma unroll
    for (int dt = 0; dt < 8; ++dt) {
        const bf16x8 vf = (bf16x8){va[dt][0], va[dt][1], va[dt][2], va[dt][3], vb[dt][0], vb[dt][1], vb[dt][2], vb[dt][3]};
        o[dt] = __builtin_amdgcn_mfma_f32_16x16x32_bf16(vf, pf, o[dt], 0, 0, 0);
    }
}
__device__ __forceinline__ const LAS float* tbl_at(const LAS float* tb, int jb) { const int jc = jb < -1 ? -1 : (jb > 137 ? 137 : jb); return tb + jc; }
template <int BUF>
__device__ __forceinline__ void attn2_chunk(LAS unsigned char* lds, const bf16* Kg, const bf16* Vg, int t0, int j, int r0, int wave, int lane, const bf16x8 (&qf)[2][4], f32x4 (&o)[2][8], float (&lsum)[2]) {
    const int Pj = t0 - 2048 + 128 * j;
    if (j + 1 < 18) attn2_stage(lds, BUF ^ 1, Kg, Vg, Pj + 128, wave, lane);
    asm volatile("" ::: "memory");
    const LAS unsigned char* Kb = lds + BUF * AT_STAGE; const LAS unsigned char* Vb = lds + BUF * AT_STAGE + AT_VOFF;
    const LAS float* tbl = (const LAS float*)(lds + AT_TBL);
#pragma unroll
    for (int gi = 0; gi < 2; ++gi) { const int r = r0 + gi;
        int l2 = lane; asm volatile("" : "+v"(l2));
        const int li2 = l2 & 15, qd2 = l2 >> 4, q2 = li2 >> 2, p2 = li2 & 3; const unsigned pt = 8u * (p2 & 1);
        {
            const int row = r + 16 * (li2 & 7), rowA = r + 16 * ((4 * qd2 + q2) & 7);
            const unsigned ko0 = row * 256 + 16 * (qd2 ^ swz_f(row)), voA = rowA * 256 + 16 * ((p2 >> 1) ^ swz_f(rowA)) + pt;
            attn5_block<true, 0, 0>(Kb, Vb, ko0, 0u, voA, 0u, qf[gi], o[gi], lsum[gi], tbl_at(tbl + 2 * 148 + 8, qd2 < 2 ? ((t0 - Pj) >> 4) + li2 - 4 * qd2 : 100000)); }
        if (j >= 12) {
            const int row0 = (r & 3) + 4 * (8 * q2 + p2), row1 = row0 + 16, rowA = (r & 3) + 4 * (8 * qd2 + q2), rowB = rowA + 16;
            const unsigned ko0 = row0 * 256 + 16 * (qd2 ^ swz_f(row0)), ko1 = row1 * 256 + 16 * (qd2 ^ swz_f(row1)), voA = rowA * 256 + 16 * ((p2 >> 1) ^ swz_f(rowA)) + pt, voB = rowB * 256 + 16 * ((p2 >> 1) ^ swz_f(rowB)) + pt;
            attn5_block<false, 0, 0>(Kb, Vb, ko0, ko1, voA, voB, qf[gi], o[gi], lsum[gi], tbl_at(tbl + 148 + 8, ((t0 - Pj) >> 2) + (r >> 2) + 4 * li2 - 8 * qd2)); }
        if (j >= 15) {
            const int row0 = 8 * q2 + p2, row1 = row0 + 4, rowA = 8 * qd2 + q2, rowB = rowA + 4;
            const unsigned ko0 = row0 * 256 + 16 * (qd2 ^ swz_f(row0)), ko1 = row1 * 256 + 16 * (qd2 ^ swz_f(row1)), voA = rowA * 256 + 16 * ((p2 >> 1) ^ swz_f(rowA)) + pt, voB = rowB * 256 + 16 * ((p2 >> 1) ^ swz_f(rowB)) + pt;
            const int jb0 = (t0 - Pj) + r + 16 * li2 - 8 * qd2; const LAS float* tb1 = tbl + 8;
            attn5_block<false, 0, 0>(Kb, Vb, ko0, ko1, voA, voB, qf[gi], o[gi], lsum[gi], tbl_at(tb1, jb0));
            attn5_block<false, 64, 8192>(Kb, Vb, ko0, ko1, voA, voB, qf[gi], o[gi], lsum[gi], tbl_at(tb1, jb0 - 32));
            attn5_block<false, 128, 16384>(Kb, Vb, ko0, ko1, voA, voB, qf[gi], o[gi], lsum[gi], tbl_at(tb1, jb0 - 64));
            attn5_block<false, 192, 24576>(Kb, Vb, ko0, ko1, voA, voB, qf[gi], o[gi], lsum[gi], tbl_at(tb1, jb0 - 96)); }
    }
    asm volatile("s_waitcnt vmcnt(0) lgkmcnt(0)" ::: "memory");
    __builtin_amdgcn_s_barrier(); asm volatile("" ::: "memory");
}
constexpr int FR_SLOT = 4096, FR_WAVE = 4 * FR_SLOT;
__device__ __forceinline__ void far_stage(LAS unsigned char* ring, int slot, const bf16* Kg, const bf16* Vg, int pos0, int lane) {
#pragma unroll
    for (int i = 0; i < 4; ++i) { const int row = 4 * (i & 1) + (lane >> 4), c = (lane & 15) ^ (2 * row);
        const bf16* src = (i < 2 ? Kg + (size_t)(pos0 + 16 * row) * 1024 : Vg + (size_t)(pos0 + 16 * row) * DIN) + 8 * c;
        __builtin_amdgcn_global_load_lds((const unsigned*)src, (LAS unsigned*)(ring + slot * FR_SLOT + i * 1024), 16, 0, 0); }
}
template <int S>
__device__ __forceinline__ void far_step(LAS unsigned char* lds, LAS unsigned char* ring, const bf16* Kg, const bf16* Vg, int t0, int jmin, int r0, int gc, int ngc, int lane, const bf16x8 (&qf)[2][4], f32x4 (&o)[2][8], float (&lsum)[2]) {
    constexpr int gi = S & 1;
    if (gc + 3 < ngc) { const int x = gc + 3; far_stage(ring, (S + 3) & 3, Kg, Vg, t0 - 2048 + 128 * (jmin + (x >> 1)) + r0 + (x & 1), lane); asm volatile("s_waitcnt vmcnt(12)" ::: "memory"); }
    else if (gc + 2 < ngc) asm volatile("s_waitcnt vmcnt(8)" ::: "memory");
    else if (gc + 1 < ngc) asm volatile("s_waitcnt vmcnt(4)" ::: "memory");
    else asm volatile("s_waitcnt vmcnt(0)" ::: "memory");
    const int Pj = t0 - 2048 + 128 * (jmin + (gc >> 1));
    int l2 = lane; asm volatile("" : "+v"(l2));
    const int li2 = l2 & 15, qd2 = l2 >> 4, q2 = li2 >> 2, p2 = li2 & 3, k = li2 & 7, kA = (4 * qd2 + q2) & 7;
    const unsigned ko0 = k * 256 + 16 * (qd2 ^ (2 * k)), voA = kA * 256 + 16 * ((p2 >> 1) ^ (2 * kA)) + 8u * (p2 & 1);
    const LAS unsigned char* Kb = ring + S * FR_SLOT;
    attn5_block<true, 0, 0>(Kb, Kb + 2048, ko0, 0u, voA, 0u, qf[gi], o[gi], lsum[gi], tbl_at((const LAS float*)(lds + AT_TBL) + 2 * 148 + 8, qd2 < 2 ? ((t0 - Pj) >> 4) + li2 - 4 * qd2 : 100000));
    asm volatile("s_waitcnt lgkmcnt(0)" ::: "memory");
}
__device__ __forceinline__ void attn2_prompt_unit(const Args& A, LAS unsigned char* lds, int h, int qt, float Mp) {
    const int tid = opaque_tid(), lane = tid & 63, wave = __builtin_amdgcn_readfirstlane(tid >> 6), li = lane & 15, quad = lane >> 4;
    const bf16* QN = (const bf16*)(A.ws + WS_QN); bf16* MIX = (bf16*)(A.ws + WS_MIX);
    const bf16* Kg = (const bf16*)(A.ws + WS_KN) + h * HD; const bf16* Vg = (const bf16*)(A.ws + WS_PROJ) + 5120 + h * HD;
    LAS float* tbl = (LAS float*)(lds + AT_TBL);
    __syncthreads();
    for (int x = tid; x < 3 * 148; x += NTHR) { const int g = x / 148, jj = x % 148 - 8; float v = -1e30f; if (jj >= 0 && jj <= 128) v = A.rel_bias[BUCKET[g][jj] * NH + h] * LOG2E - Mp; tbl[x] = v; }
    const int t0 = qt * 256, r0 = 2 * wave;
    bf16x8 qf[2][4]; f32x4 o[2][8]; float lsum[2] = {0.f, 0.f};
#pragma unroll
    for (int gi = 0; gi < 2; ++gi) {
#pragma unroll
        for (int ks = 0; ks < 4; ++ks) qf[gi][ks] = ld16(QN + (size_t)(t0 + 16 * li + r0 + gi) * 1024 + h * HD + 32 * ks + 8 * quad);
#pragma unroll
        for (int dt = 0; dt < 8; ++dt) o[gi][dt] = (f32x4){0.f, 0.f, 0.f, 0.f};
    }
    asm volatile("s_waitcnt vmcnt(0) lgkmcnt(0)" ::: "memory");
    __syncthreads();
    const int jmin = (16 - 2 * qt) > 0 ? (16 - 2 * qt) : 0;
    const int jn = jmin > 12 ? jmin : 12;
    if (jmin < 12) {
        LAS unsigned char* ring = lds + wave * FR_WAVE; const int ngc = 2 * (12 - jmin);
        far_stage(ring, 0, Kg, Vg, t0 - 2048 + 128 * jmin + r0, lane); far_stage(ring, 1, Kg, Vg, t0 - 2048 + 128 * jmin + r0 + 1, lane); far_stage(ring, 2, Kg, Vg, t0 - 2048 + 128 * (jmin + 1) + r0, lane);
#pragma unroll 1
        for (int gc = 0; gc < ngc; gc += 4) {
            far_step<0>(lds, ring, Kg, Vg, t0, jmin, r0, gc, ngc, lane, qf, o, lsum); far_step<1>(lds, ring, Kg, Vg, t0, jmin, r0, gc + 1, ngc, lane, qf, o, lsum);
            far_step<2>(lds, ring, Kg, Vg, t0, jmin, r0, gc + 2, ngc, lane, qf, o, lsum); far_step<3>(lds, ring, Kg, Vg, t0, jmin, r0, gc + 3, ngc, lane, qf, o, lsum);
        }
        asm volatile("s_waitcnt vmcnt(0) lgkmcnt(0)" ::: "memory");
        __builtin_amdgcn_s_barrier(); asm volatile("" ::: "memory");
    }
    attn2_stage(lds, 0, Kg, Vg, t0 - 2048 + 128 * jn, wave, lane);
    asm volatile("s_waitcnt vmcnt(0)" ::: "memory");
    __builtin_amdgcn_s_barrier(); asm volatile("" ::: "memory");
#pragma unroll 1
    for (int j = jn; j < 18; j += 2) {
        attn2_chunk<0>(lds, Kg, Vg, t0, j, r0, wave, lane, qf, o, lsum);
        attn2_chunk<1>(lds, Kg, Vg, t0, j + 1, r0, wave, lane, qf, o, lsum);
    }
#pragma unroll
    for (int gi = 0; gi < 2; ++gi) {
        float l = lsum[gi]; l += __shfl_xor(l, 16); l += __shfl_xor(l, 32);
        const float inv = 1.0f / l;
        bf16* orow = MIX + (size_t)(t0 + 16 * li + r0 + gi) * DM + DATT + h * HD + 4 * quad;
#pragma unroll
        for (int dt = 0; dt < 8; ++dt) { v2u w; w.x = pg8::cvt_pk_bf16(o[gi][dt][0] * inv, o[gi][dt][1] * inv); w.y = pg8::cvt_pk_bf16(o[gi][dt][2] * inv, o[gi][dt][3] * inv); *(GAS v2u*)(orow + 16 * dt) = w; }
    }
}
__device__ __forceinline__ void load_q_frags(bf16x8 (&qf)[4], const bf16* qrow, const float* gq, int quad, float scale = QSCALE) {
    float f[32];
#pragma unroll
    for (int ks = 0; ks < 4; ++ks) unpack8(*(const GAS v4u*)(qrow + 32 * ks + 8 * quad), f + 8 * ks);
    float ss = 0.f;
#pragma unroll
    for (int i = 0; i < 32; ++i) ss += f[i] * f[i];
    ss += __shfl_xor(ss, 16); ss += __shfl_xor(ss, 32);
    const float sc = scale / sqrtf(ss * (1.f / HD) + EPS);
#pragma unroll
    for (int ks = 0; ks < 4; ++ks) { const f32x4 g0 = *(const GAS f32x4*)(gq + 32 * ks + 8 * quad), g1 = *(const GAS f32x4*)(gq + 32 * ks + 8 * quad + 4); const float* e = f + 8 * ks;
        v4u w; w.x = pg8::cvt_pk_bf16(e[0] * sc * g0[0], e[1] * sc * g0[1]); w.y = pg8::cvt_pk_bf16(e[2] * sc * g0[2], e[3] * sc * g0[3]); w.z = pg8::cvt_pk_bf16(e[4] * sc * g1[0], e[5] * sc * g1[1]); w.w = pg8::cvt_pk_bf16(e[6] * sc * g1[2], e[7] * sc * g1[3]);
        qf[ks] = __builtin_bit_cast(bf16x8, w); }
}
constexpr int PL_KV = (WBUF + NSAMP) / 32, PL_CONV = MT / 16, PL_ITEMS = PL_KV + PL_CONV;
__device__ __forceinline__ void postlite_item(const Args& A, int item) {
    const int tid = opaque_tid(), lane = tid & 63, wave = __builtin_amdgcn_readfirstlane(tid >> 6);
    const bf16* PROJ = (const bf16*)(A.ws + WS_PROJ); bf16* MIX = (bf16*)(A.ws + WS_MIX);
    if (item < PL_KV) {
        v4u kw[4][2], vw[4][2];
#pragma unroll
        for (int q = 0; q < 4; ++q) { const int tk_ = (SEQ - WBUF) + item * 32 + wave * 4 + q; const bf16* prow = PROJ + (size_t)tk_ * DIN; const GAS v4u* pk = tk_ >= SEQ ? (const GAS v4u*)(prow + 4096 + lane * 16) : (const GAS v4u*)((const bf16*)(A.ws + WS_KN) + (size_t)tk_ * 1024 + lane * 16); const GAS v4u* pv = (const GAS v4u*)(prow + 5120 + lane * 16);
            kw[q][0] = pk[0]; kw[q][1] = pk[1]; vw[q][0] = pv[0]; vw[q][1] = pv[1]; }
        f32x4 g[4];
#pragma unroll
        for (int j = 0; j < 4; ++j) g[j] = *(const GAS f32x4*)(A.k_norm + (lane & 7) * 16 + 4 * j);
#pragma unroll
        for (int q = 0; q < 4; ++q) { const int tok = (SEQ - WBUF) + item * 32 + wave * 4 + q;
            float* ko; float* vo;
            if (tok >= SEQ) { ko = A.out + O_SK + (size_t)(tok - SEQ) * 1024; vo = A.out + O_SV + (size_t)(tok - SEQ) * 1024; }
            else { ko = A.out + O_PK + (size_t)(tok - (SEQ - WBUF)) * 1024; vo = A.out + O_PV + (size_t)(tok - (SEQ - WBUF)) * 1024; }
            float f[16]; unpack8(kw[q][0], f); unpack8(kw[q][1], f + 8);
            float ss = 0.f;
#pragma unroll
            for (int j = 0; j < 16; ++j) ss += f[j] * f[j];
            ss += __shfl_xor(ss, 1); ss += __shfl_xor(ss, 2); ss += __shfl_xor(ss, 4);
            const float rstd = 1.0f / sqrtf(ss * (1.f / HD) + EPS);
            GAS f32x4* o = (GAS f32x4*)(ko + lane * 16);
            if (tok >= SEQ) {
#pragma unroll
                for (int j = 0; j < 4; ++j) __builtin_nontemporal_store((f32x4){f[4 * j] * rstd * g[j][0], f[4 * j + 1] * rstd * g[j][1], f[4 * j + 2] * rstd * g[j][2], f[4 * j + 3] * rstd * g[j][3]}, o + j);
            } else {
#pragma unroll
                for (int j = 0; j < 4; ++j) __builtin_nontemporal_store((f32x4){f[4 * j], f[4 * j + 1], f[4 * j + 2], f[4 * j + 3]}, o + j); }
            unpack8(vw[q][0], f); unpack8(vw[q][1], f + 8);
            GAS f32x4* ov = (GAS f32x4*)(vo + lane * 16);
#pragma unroll
            for (int j = 0; j < 4; ++j) __builtin_nontemporal_store((f32x4){f[4 * j], f[4 * j + 1], f[4 * j + 2], f[4 * j + 3]}, ov + j); }
    } else {
        const int tb = (item - PL_KV) * 16;
#pragma unroll 2
        for (int it = tid; it < 16 * (DCONV / 8); it += NTHR) {
            const int tok = tb + (it >> 7), c8 = (it & 127) * 8;
            const bool samp = tok >= SEQ; const int b = (tok - SEQ) >> 3, i = samp ? ((tok - SEQ) & 7) : tok;
            v4u xw[3], cw[3]; f32x4 s0[2], s1[2];
#pragma unroll
            for (int k = 0; k < 3; ++k) { const int ii = i - 2 + k; const bf16* pr = PROJ + (size_t)(tok - 2 + k) * DIN;
                if (ii >= 0) { xw[k] = *(const GAS v4u*)(pr + c8); cw[k] = *(const GAS v4u*)(pr + 2048 + c8); } else { xw[k] = (v4u){0u, 0u, 0u, 0u}; cw[k] = (v4u){0u, 0u, 0u, 0u}; } }
            if (samp && i < 2) { const float* st = A.state_conv + ((size_t)b * 2) * DCONV + c8; s0[0] = *(const GAS f32x4*)(st); s0[1] = *(const GAS f32x4*)(st + 4); s1[0] = *(const GAS f32x4*)(st + DCONV); s1[1] = *(const GAS f32x4*)(st + DCONV + 4); }
            const v4u bw = *(const GAS v4u*)(PROJ + (size_t)tok * DIN + 1024 + c8);
            float u[3][8];
#pragma unroll
            for (int k = 0; k < 3; ++k) { float xc[8], cg[8]; unpack8(xw[k], xc); unpack8(cw[k], cg);
#pragma unroll
                for (int j = 0; j < 8; ++j) u[k][j] = cg[j] * xc[j]; }
            if (samp && i < 2) {
#pragma unroll
                for (int j = 0; j < 8; ++j) { const float st0 = j < 4 ? s0[0][j] : s0[1][j - 4], st1 = j < 4 ? s1[0][j] : s1[1][j - 4];
                    if (i == 0) { u[0][j] = st0; u[1][j] = st1; } else { u[0][j] = st1; } } }
            float bg[8]; unpack8(bw, bg);
            float y[8];
#pragma unroll
            for (int j = 0; j < 8; ++j) y[j] = bg[j] * (u[0][j] * A.conv_w[c8 + j] + u[1][j] * A.conv_w[DCONV + c8 + j] + u[2][j] * A.conv_w[2 * DCONV + c8 + j]);
            v4u w; w.x = pk2(y[0], y[1]); w.y = pk2(y[2], y[3]); w.z = pk2(y[4], y[5]); w.w = pk2(y[6], y[7]);
            *(GAS v4u*)(MIX + (size_t)tok * DM + c8) = w;
            float* co = nullptr;
            if (samp) { if (i >= 6) co = A.out + O_SC + ((size_t)b * 2 + (i - 6)) * DCONV + c8; }
            else if (tok >= SEQ - 2) co = A.out + O_PC + (size_t)(tok - (SEQ - 2)) * DCONV + c8;
            if (co) {
#pragma unroll
                for (int j = 0; j < 8; ++j) co[j] = u[2][j]; }
        }
    }
}
__device__ __forceinline__ int att_mult(int dist) { return (dist <= 128 ? 1 : 0) + (((dist & 3) == 0 && dist <= 512) ? 1 : 0) + (((dist & 15) == 0 && dist <= 2048) ? 1 : 0); }
constexpr int SROWS = 1288, S_TBL = 0, S_Q = 8256, S_P = S_Q + 4096, S_OP = S_P + SROWS * 32, S_LP = S_OP + 65536, S_KT = 122880, S_END = S_KT + 32768;
__device__ __forceinline__ void attn_sample_unit(const Args& A, LAS unsigned char* lds, int b, int h, float Mp) {
    const int tid = opaque_tid(), lane = tid & 63, wave = __builtin_amdgcn_readfirstlane(tid >> 6);
    const bf16* PROJ = (const bf16*)(A.ws + WS_PROJ); const bf16* QN = (const bf16*)(A.ws + WS_QN); const bf16* KN = (const bf16*)(A.ws + WS_KN); bf16* MIX = (bf16*)(A.ws + WS_MIX);
    LAS float* tblS = (LAS float*)(lds + S_TBL); LAS float* q_s = (LAS float*)(lds + S_Q); LAS float* P_T = (LAS float*)(lds + S_P); LAS float* Opart = (LAS float*)(lds + S_OP); LAS float* lpart = (LAS float*)(lds + S_LP);
    __syncthreads();
    {
        LAS float* rb = q_s; LAS unsigned* bkw = (LAS unsigned*)(q_s + 32);
        if (tid < 32) rb[tid] = A.rel_bias[tid * NH + h] * LOG2E - Mp;
        else if (tid < 32 + 99) bkw[tid - 32] = ((const unsigned*)&BUCKET[0][0])[tid - 32];
        __syncthreads();
        const LAS unsigned char* bkb = (const LAS unsigned char*)bkw;
        for (int x = tid; x < 2064; x += NTHR) { float v = -1e30f;
            if (x <= 2055) { const int c = att_mult(x); if (c > 0) { const int bk = x <= 128 ? bkb[x] : (((x & 3) == 0 && x <= 512) ? bkb[132 + (x >> 2)] : bkb[264 + (x >> 4)]);
                v = (c == 1 ? 0.f : (c == 2 ? 1.f : 1.5849625007211562f)) + rb[bk]; } }
            tblS[x] = v; }
    }
    __syncthreads();
    {
        const int li = lane & 15, quad = lane >> 4;
        bf16x8 qf[4];
#pragma unroll
        for (int ks = 0; ks < 4; ++ks) qf[ks] = (bf16x8){0, 0, 0, 0, 0, 0, 0, 0};
        load_q_frags(qf, PROJ + (size_t)(SEQ + b * 8 + (li & 7)) * DIN + 3072 + h * HD, A.q_norm, quad);
        const float* kbase = A.cache_k + ((size_t)b * WBUF * NH + h) * HD + 4 * (lane & 31);
        f32x4 ka[8], kb[8];
        const int half_ = lane >> 5, l32_ = lane & 31;
        LAS unsigned char* ktile = lds + S_KT + wave * 4096;
#define SC_LOAD(dst, ti) do { _Pragma("unroll") for (int x_ = 0; x_ < 8; ++x_) { const int n_ = 16 * (ti) + 2 * x_ + half_, p_ = n_ < 768 ? ((n_ >> 3) * 16 + (n_ & 7)) : n_ + 768; \
            dst[x_] = __builtin_nontemporal_load((const GAS f32x4*)(kbase + (size_t)p_ * (NH * HD))); } } while (0)
#define SC_TILE(src_, ti) do { f32x4 s_ = (f32x4){0.f, 0.f, 0.f, 0.f}; \
        _Pragma("unroll") for (int x_ = 0; x_ < 8; ++x_) { const int row_ = 2 * x_ + half_; v2u w_; w_.x = pg8::cvt_pk_bf16(src_[x_][0], src_[x_][1]); w_.y = pg8::cvt_pk_bf16(src_[x_][2], src_[x_][3]); \
            *(LAS v2u*)(ktile + row_ * 256 + 16 * ((l32_ >> 1) ^ row_) + 8 * (l32_ & 1)) = w_; }              \
        asm volatile("s_waitcnt lgkmcnt(0)" ::: "memory"); \
        _Pragma("unroll") for (int ks = 0; ks < 4; ++ks) { const bf16x8 kf_ = *(const LAS bf16x8*)(ktile + li * 256 + 16 * ((4 * ks + quad) ^ li)); \
            s_ = __builtin_amdgcn_mfma_f32_16x16x32_bf16(kf_, qf[ks], s_, 0, 0, 0); } \
        if (li < 8) { _Pragma("unroll") for (int rg = 0; rg < 4; ++rg) { const int n_ = 16 * (ti) + 4 * quad + rg, p_ = n_ < 768 ? ((n_ >> 3) * 16 + (n_ & 7)) : n_ + 768, dist_ = WBUF + li - p_; \
            P_T[n_ * 8 + li] = __builtin_amdgcn_exp2f(s_[rg] + tblS[dist_ < 0 ? 2056 : dist_]); } } } while (0)
        SC_LOAD(ka, wave);
#pragma unroll 1
        for (int k = 0; k < 8; k += 2) {
            SC_LOAD(kb, wave + NWAVES * (k + 1));
            SC_TILE(ka, wave + NWAVES * k);
            SC_LOAD(ka, wave + NWAVES * (k + 2));
            SC_TILE(kb, wave + NWAVES * (k + 1));
        }
        SC_LOAD(kb, wave + NWAVES * 9);
        SC_TILE(ka, wave + NWAVES * 8);
        SC_TILE(kb, wave + NWAVES * 9);
#undef SC_LOAD
#undef SC_TILE
        if (wave == 0) {
            f32x4 s_ = (f32x4){0.f, 0.f, 0.f, 0.f};
            bf16x8 kn[4]; load_q_frags(kn, PROJ + (size_t)(SEQ + b * 8 + (li & 7)) * DIN + 4096 + h * HD, A.k_norm, quad, 1.0f);
#pragma unroll
            for (int ks = 0; ks < 4; ++ks) s_ = __builtin_amdgcn_mfma_f32_16x16x32_bf16(kn[ks], qf[ks], s_, 0, 0, 0);
            if (li < 8 && quad < 2) {
#pragma unroll
                for (int rg = 0; rg < 4; ++rg) { const int rr = 4 * quad + rg, dist_ = li - rr; P_T[(SROWS - 8 + rr) * 8 + li] = __builtin_amdgcn_exp2f(s_[rg] + tblS[dist_ < 0 ? 2056 : dist_]); } }
        }
    }
    __syncthreads();
    {
        const int half = lane >> 5, l32 = lane & 31;
        f32x4 o[8]; float la[8];
#pragma unroll
        for (int i = 0; i < 8; ++i) { o[i] = (f32x4){0.f, 0.f, 0.f, 0.f}; la[i] = 0.f; }
        const float* vbase = A.cache_v + ((size_t)b * WBUF * NH + h) * HD + 4 * l32;
        f32x4 va[8], vb[8];
#define PV_LOAD(dst, k0) do { _Pragma("unroll") for (int u = 0; u < 8; ++u) { const int n_ = 2 * (wave + NWAVES * ((k0) + u)) + half, p_ = n_ < 768 ? ((n_ >> 3) * 16 + (n_ & 7)) : n_ + 768; dst[u] = __builtin_nontemporal_load((const GAS f32x4*)(vbase + (size_t)p_ * (NH * HD))); } } while (0)
#define PV_ACC(src_, k0) do { _Pragma("unroll") for (int u = 0; u < 8; ++u) { const int n_ = 2 * (wave + NWAVES * ((k0) + u)) + half; \
            const f32x4 pa = *(const LAS f32x4*)(P_T + n_ * 8), pb = *(const LAS f32x4*)(P_T + n_ * 8 + 4); \
            _Pragma("unroll") for (int i = 0; i < 4; ++i) { o[i] += src_[u] * pa[i]; la[i] += pa[i]; o[4 + i] += src_[u] * pb[i]; la[4 + i] += pb[i]; } } } while (0)
        PV_LOAD(va, 0);
#pragma unroll 1
        for (int k0 = 0; k0 < 64; k0 += 16) {
            PV_LOAD(vb, k0 + 8);
            PV_ACC(va, k0);
            PV_LOAD(va, k0 + 16);
            PV_ACC(vb, k0 + 8);
        }
        PV_LOAD(vb, 72);
        PV_ACC(va, 64);
        PV_ACC(vb, 72);
#undef PV_LOAD
#undef PV_ACC
        if (wave < 4) {
            const int n = SROWS - 8 + 2 * wave + half; const v2u w = *(const GAS v2u*)(PROJ + (size_t)(SEQ + b * 8 + (n - (SROWS - 8))) * DIN + 5120 + h * HD + 4 * l32);
            const f32x4 vv = (f32x4){bf_lo(w.x), bf_hi(w.x), bf_lo(w.y), bf_hi(w.y)};
            const f32x4 pa = *(const LAS f32x4*)(P_T + n * 8), pb = *(const LAS f32x4*)(P_T + n * 8 + 4);
#pragma unroll
            for (int i = 0; i < 4; ++i) { o[i] += vv * pa[i]; la[i] += pa[i]; o[4 + i] += vv * pb[i]; la[4 + i] += pb[i]; }
        }
        const int hw = wave * 2 + half;
#pragma unroll
        for (int i = 0; i < 8; ++i) { *(LAS f32x4*)(Opart + (hw * 8 + i) * 128 + 4 * l32) = o[i]; if (l32 == 0) lpart[hw * 8 + i] = la[i]; }
    }
    __syncthreads();
    {   const int i = tid >> 6, d = 2 * (tid & 63); float a0 = 0.f, a1 = 0.f, l = 0.f;
#pragma unroll
        for (int w = 0; w < 2 * NWAVES; ++w) { const f32x2 v = *(const LAS f32x2*)(Opart + (w * 8 + i) * 128 + d); a0 += v.x; a1 += v.y; l += lpart[w * 8 + i]; }
        const float inv = 1.0f / l;
        *(GAS unsigned*)(MIX + (size_t)(SEQ + b * 8 + i) * DM + DATT + h * HD + d) = pk2(a0 * inv, a1 * inv);
    }
}
__device__ __forceinline__ void phase_attn(const Args& A, LAS unsigned char* lds, int vcu, int G) {
    const float Mp = softmax_bound_l2(A, threadIdx.x & 63);
    for (int pass = 0; pass < 2; ++pass) {
        const bool prompt = ((vcu & 1) == 0) == (pass == 0);
#ifndef REP_PR
#define REP_PR 1
#endif
#ifndef REP_SA
#define REP_SA 1
#endif
        if (prompt) { for (int rep = 0; rep < REP_PR; ++rep) for (int u = vcu; u < NH * (SEQ / 256); u += G) attn2_prompt_unit(A, lds, u >> 5, u & 31, Mp); }
        else { for (int rep = 0; rep < REP_SA; ++rep) for (int u = vcu; u < DBATCH * NH; u += G) attn_sample_unit(A, lds, u >> 3, u & 7, Mp); }
    }
    volatile LAS int* qslot = (volatile LAS int*)(lds + LDS_ST_OFF + 16);
    for (;;) {
        __syncthreads();
        if (threadIdx.x == 0) *qslot = (int)__hip_atomic_fetch_add((unsigned*)(A.ws + WS_CTL), 1u, __ATOMIC_RELAXED, __HIP_MEMORY_SCOPE_AGENT);
        __syncthreads();
        const int item = *qslot;
        if (item >= PL_ITEMS + PL_GU) break;
        if (item < PL_ITEMS) postlite_item(A, item); else convert_gu_item(A, lds, item - PL_ITEMS);
    }
}

template <int MB, int NB, class Epi>
__device__ __forceinline__ void skinny_gemm(const bf16* A, const bf16* Bt, int K, int tile, LAS unsigned char* lds, const Epi& E) {
    const int tid = opaque_tid(), lane = tid & 63, wave = __builtin_amdgcn_readfirstlane(tid >> 6), fr = lane & 15, fq = lane >> 4;
    constexpr int RT = 256 / (16 * MB), W = 16 * NB, SLOT = 16 * MB * W * 4;
    const int rt = tile % RT, ct = tile / RT;
    const int ksl = K / NWAVES, nsteps = ksl / 32;
    const bf16* ap = A + (size_t)(16 * MB * rt + fr) * K + wave * ksl + 8 * fq;
    const bf16* bp = Bt + (size_t)(W * ct + fr) * K + wave * ksl + 8 * fq;
    f32x4 acc[MB][NB];
#pragma unroll
    for (int mi = 0; mi < MB; ++mi)
#pragma unroll
        for (int ni = 0; ni < NB; ++ni) acc[mi][ni] = (f32x4){0.f, 0.f, 0.f, 0.f};
    constexpr int DEPTH = (MB + NB <= 6) ? 6 : 3;
    bf16x8 af[DEPTH][MB], bfr[DEPTH][NB];
#define SK_LOAD(d, s) do { _Pragma("unroll") for (int mi = 0; mi < MB; ++mi) af[d][mi] = ld16(ap + (size_t)(16 * mi) * K + 32 * (s)); _Pragma("unroll") for (int ni = 0; ni < NB; ++ni) bfr[d][ni] = ld16(bp + (size_t)(16 * ni) * K + 32 * (s)); } while (0)
#define SK_MMA(d) do { _Pragma("unroll") for (int mi = 0; mi < MB; ++mi) _Pragma("unroll") for (int ni = 0; ni < NB; ++ni) acc[mi][ni] = __builtin_amdgcn_mfma_f32_16x16x32_bf16(bfr[d][ni], af[d][mi], acc[mi][ni], 0, 0, 0); } while (0)
#pragma unroll
    for (int d = 0; d < DEPTH; ++d) if (d < nsteps) SK_LOAD(d, d);
#pragma unroll 1
    for (int s = 0; s < nsteps; s += DEPTH) {
#pragma unroll
        for (int d = 0; d < DEPTH; ++d) { if (s + d < nsteps) { SK_MMA(d); if (s + d + DEPTH < nsteps) SK_LOAD(d, s + d + DEPTH); } }
    }
#undef SK_LOAD
#undef SK_MMA
    LAS float* slot = (LAS float*)(lds + (wave & 3) * SLOT);
    __syncthreads();
    if (wave >= 4) {
#pragma unroll
        for (int mi = 0; mi < MB; ++mi)
#pragma unroll
            for (int ni = 0; ni < NB; ++ni) *(LAS f32x4*)(slot + (16 * mi + fr) * W + 16 * ni + 4 * fq) = acc[mi][ni];
    }
    __syncthreads();
    if (wave < 4) {
#pragma unroll
        for (int mi = 0; mi < MB; ++mi)
#pragma unroll
            for (int ni = 0; ni < NB; ++ni) acc[mi][ni] += *(const LAS f32x4*)(slot + (16 * mi + fr) * W + 16 * ni + 4 * fq);
    }
    __syncthreads();
    if (wave < 4) {
#pragma unroll
        for (int mi = 0; mi < MB; ++mi)
#pragma unroll
            for (int ni = 0; ni < NB; ++ni) *(LAS f32x4*)(slot + (16 * mi + fr) * W + 16 * ni + 4 * fq) = acc[mi][ni];
    }
    __syncthreads();
    constexpr int NCH = 16 * MB * W / 4;
#pragma unroll
    for (int i = 0; i < NCH / NTHR; ++i) { const int ch = tid + NTHR * i, row = ch / (W / 4), c4 = ch % (W / 4);
        f32x4 v = *(const LAS f32x4*)(lds + (row * W + 4 * c4) * 4);
#pragma unroll
        for (int sl = 1; sl < 4; ++sl) v += *(const LAS f32x4*)(lds + sl * SLOT + (row * W + 4 * c4) * 4);
        E(16 * MB * rt + row, W * ct + 4 * c4, ct, v); }
    __syncthreads();
}
template <int N> __device__ __forceinline__ void wait_vm() { asm volatile("s_waitcnt vmcnt(%0)" :: "n"(N) : "memory"); }
template <int MB, int NB, int KC, int NSLOT, int NCH, class Epi>
__device__ __forceinline__ void skinny2(const bf16* A, const bf16* Bt, int tile, LAS unsigned char* lds, const Epi& E) {
    constexpr int K = KC * NCH, RT = 256 / (16 * MB), W = 16 * NB, R = 16 * (MB + NB), ROWB = KC * 2, CHB = R * ROWB, LPR = ROWB / 16, RPI = 64 / LPR, NI = R / RPI, NL = NI / 8, NJ = MB * NB / 8, KS = KC / 32;
    static_assert(NI % 8 == 0 && NSLOT * CHB <= 131072 && (MB * NB) % 8 == 0 && 8 % MB == 0 && LPR >= 16 && NSLOT >= 3, "skinny2 shape");
    const int tid = opaque_tid(), lane = tid & 63, wave = __builtin_amdgcn_readfirstlane(tid >> 6), fr = lane & 15, fq = lane >> 4;
    const int rt = tile % RT, ct = tile / RT;
    const bf16* gp[NL];
#pragma unroll
    for (int i = 0; i < NL; ++i) { const int q = wave + 8 * i, row = q * RPI + lane / LPR, piece = (lane % LPR) ^ (row & 15);
        const bf16* rp = row < 16 * MB ? A + (size_t)(16 * MB * rt + row) * K : Bt + (size_t)(W * ct + row - 16 * MB) * K; gp[i] = rp + 8 * piece; }
    const int mi = wave % MB, g = wave / MB;
    f32x4 acc[NJ];
#pragma unroll
    for (int j = 0; j < NJ; ++j) acc[j] = (f32x4){0.f, 0.f, 0.f, 0.f};
    const unsigned aoff = (unsigned)(16 * mi + fr) * ROWB, boff = (unsigned)(16 * MB + 16 * NJ * g + fr) * ROWB;
#define SK2_STAGE(c) do { _Pragma("unroll") for (int i_ = 0; i_ < NL; ++i_) __builtin_amdgcn_global_load_lds((const unsigned*)(gp[i_] + (size_t)(c) * KC), (LAS unsigned*)(lds + ((c) % NSLOT) * CHB + (wave + 8 * i_) * 1024), 16, 0, 0); } while (0)
#pragma unroll
    for (int c = 0; c < NSLOT - 1; ++c) if (c < NCH) SK2_STAGE(c);
#pragma unroll
    for (int c = 0; c < NCH; ++c) {
        const int ahead = (NCH - 1 - c) < (NSLOT - 2) ? (NCH - 1 - c) : (NSLOT - 2);
        if (ahead >= 2) wait_vm<2 * NL>(); else if (ahead == 1) wait_vm<NL>(); else wait_vm<0>();
        __builtin_amdgcn_s_barrier(); asm volatile("" ::: "memory");
        if (c + NSLOT - 1 < NCH) SK2_STAGE(c + NSLOT - 1);
        const LAS unsigned char* sb = lds + (c % NSLOT) * CHB;
#pragma unroll
        for (int kk = 0; kk < KS; ++kk) { const unsigned po = 16u * (unsigned)((4 * kk + fq) ^ fr);
            const bf16x8 af = *(const LAS bf16x8*)(sb + aoff + po);
#pragma unroll
            for (int j = 0; j < NJ; ++j) { const bf16x8 bf = *(const LAS bf16x8*)(sb + boff + j * 16 * ROWB + po); acc[j] = __builtin_amdgcn_mfma_f32_16x16x32_bf16(bf, af, acc[j], 0, 0, 0); } }
    }
#undef SK2_STAGE
    asm volatile("s_waitcnt lgkmcnt(0)" ::: "memory");
    __syncthreads();
#pragma unroll
    for (int j = 0; j < NJ; ++j) *(LAS f32x4*)(lds + ((16 * mi + fr) * W + 16 * (NJ * g + j) + 4 * fq) * 4) = acc[j];
    __syncthreads();
    constexpr int NCHK = 16 * MB * W / 4;
#pragma unroll
    for (int i = 0; i < NCHK / NTHR; ++i) { const int ch = tid + NTHR * i, row = ch / (W / 4), c4 = ch % (W / 4);
        const f32x4 v = *(const LAS f32x4*)(lds + (row * W + 4 * c4) * 4);
        E(16 * MB * rt + row, W * ct + 4 * c4, ct, v); }
    __syncthreads();
}
struct SkProj { bf16* PROJ; __device__ __forceinline__ void operator()(int row, int col, int, f32x4 v) const { v2u w; w.x = pg8::cvt_pk_bf16(v[0], v[1]); w.y = pg8::cvt_pk_bf16(v[2], v[3]); *(GAS v2u*)(PROJ + (size_t)(SEQ + row) * DIN + col) = w; } };
struct SkRes1 { const float* xs; bf16* X1b; float* SSQ;
    __device__ __forceinline__ void operator()(int row, int col, int ct, f32x4 v) const {
        const f32x4 o = *(const GAS f32x4*)(xs + (size_t)row * DM + col) + v; const size_t off = (size_t)(SEQ + row) * DM + col;
        v2u pk; pk.x = pg8::cvt_pk_bf16(o[0], o[1]); pk.y = pg8::cvt_pk_bf16(o[2], o[3]); *(GAS v2u*)(X1b + off) = pk;
        float ss = (o[0] * o[0] + o[1] * o[1]) + (o[2] * o[2] + o[3] * o[3]); ss += __shfl_xor(ss, 1); ss += __shfl_xor(ss, 2); ss += __shfl_xor(ss, 4); ss += __shfl_xor(ss, 8);
        if ((threadIdx.x & 15) == 0) SSQ[(size_t)(SEQ + row) * 32 + ct] = ss; } };
struct SkOut { const bf16* X1b; float* out; __device__ __forceinline__ void operator()(int row, int col, int, f32x4 v) const { const size_t off = (size_t)(SEQ + row) * DM + col; const v2u w = *(const GAS v2u*)(X1b + off);
        *(GAS f32x4*)(out + off) = (f32x4){bf_lo(w.x), bf_hi(w.x), bf_lo(w.y), bf_hi(w.y)} + v; } };

#define XB_TMO      128
#define XB_XCNT(j)  (256  + 64 * (j))
#define XB_XSUB(j)  (1280 + 64 * (j))
#define XB_XGEN(j)  (2304 + 64 * (j))
#define XB_TOP      3328
#define XB_TOPGEN   3392
#define XCD_BAR_WORDS 3456
#define XB_SPIN_CAP (1u << 18)
__device__ __forceinline__ unsigned xb_ld(unsigned* p)              { return __hip_atomic_load(p, __ATOMIC_RELAXED, __HIP_MEMORY_SCOPE_AGENT); }
__device__ __forceinline__ unsigned xb_add(unsigned* p, unsigned v) { return __hip_atomic_fetch_add(p, v, __ATOMIC_RELAXED, __HIP_MEMORY_SCOPE_AGENT); }
__device__ __forceinline__ unsigned xb_xcc_id() { return (unsigned)__builtin_amdgcn_s_getreg((3 << 11) | 20) & 0xFu; }
#define XB_SPIN(cond, bar) do { unsigned _sp = 0; while (cond) { __builtin_amdgcn_s_sleep(1); \
    if ((++_sp & 255u) == 0u) { if (xb_ld(&(bar)[XB_TMO])) break; if (_sp > XB_SPIN_CAP) { atomicAdd(&(bar)[XB_TMO], 1u); break; } } } } while (0)
struct XcdBarrier { unsigned* bar; unsigned x; volatile LAS unsigned* st; };
__device__ __forceinline__ XcdBarrier xcd_barrier_post(unsigned* bar, volatile LAS unsigned* st) {
    XcdBarrier b; b.bar = bar; b.x = xb_xcc_id(); b.st = st;
    if (threadIdx.x == 0) (void)xb_add(&bar[XB_XCNT(b.x)], 1u);
    return b;
}
__device__ __forceinline__ void xcd_barrier_complete(unsigned* bar, unsigned x, unsigned& nloc, unsigned& nx) {
    const unsigned G = gridDim.x * gridDim.y * gridDim.z;
    unsigned sum, cnt, mine, sp = 0u;
    for (;;) {
        sum = 0u; cnt = 0u; mine = 0u;
#pragma unroll
        for (unsigned j = 0; j < 16; ++j) { const unsigned c = xb_ld(&bar[XB_XCNT(j)]); sum += c; cnt += (c > 0u) ? 1u : 0u; mine = (j == x) ? c : mine; }
        if (sum == G) break;
        __builtin_amdgcn_s_sleep(1);
        if ((++sp & 255u) == 0u) { if (xb_ld(&bar[XB_TMO])) break; if (sp > XB_SPIN_CAP) { atomicAdd(&bar[XB_TMO], 1u); break; } }
    }
    nloc = mine > 0u ? mine : 1u; nx = cnt > 0u ? cnt : 1u;
}
__device__ __forceinline__ void xcd_barrier(const XcdBarrier& b) {
    asm volatile("s_waitcnt vmcnt(0)" ::: "memory");
    __syncthreads();
    if (threadIdx.x == 0) {
        unsigned* bar = b.bar;
        __builtin_amdgcn_s_waitcnt(0);
        unsigned nloc = b.st[0], nx = b.st[1];
        if (nloc == 0u) { xcd_barrier_complete(bar, b.x, nloc, nx); b.st[0] = nloc; b.st[1] = nx; }
        const unsigned old = xb_add(&bar[XB_XSUB(b.x)], 1u);
        const unsigned gen = old / nloc;
        if (old + 1u == (gen + 1u) * nloc) {
            __builtin_amdgcn_fence(__ATOMIC_RELEASE, "agent");
            asm volatile("s_waitcnt vmcnt(0)" ::: "memory");
            const unsigned og = xb_add(&bar[XB_TOP], 1u);
            const unsigned tg = og / nx;
            if (og + 1u == (tg + 1u) * nx) xb_add(&bar[XB_TOPGEN], 1u);
            else XB_SPIN(xb_ld(&bar[XB_TOPGEN]) == tg, bar);
            __builtin_amdgcn_fence(__ATOMIC_ACQUIRE, "agent");
            xb_add(&bar[XB_XGEN(b.x)], 1u);
            asm volatile("s_waitcnt vmcnt(0)" ::: "memory");
        } else {
            XB_SPIN(xb_ld(&bar[XB_XGEN(b.x)]) == gen, bar);
            __builtin_amdgcn_fence(__ATOMIC_ACQUIRE, "agent");
            asm volatile("s_waitcnt vmcnt(0)" ::: "memory");
        }
    }
    __syncthreads();
}
constexpr int CW_BAR = 4096;
constexpr size_t CTL_ZERO_BYTES = 65536;

namespace cg = cooperative_groups;
__device__ __forceinline__ int vcu_of(int bx, int G) { return (G % 8 == 0) ? (bx % 8) * (G / 8) + bx / 8 : bx; }
__global__ void __launch_bounds__(NTHR, 2) fwd_mega(Args A) {
    extern __shared__ __attribute__((aligned(16))) unsigned char lds_raw[];
    LAS unsigned char* lds = (LAS unsigned char*)lds_raw;
    const int G = gridDim.x, bx = blockIdx.x, vcu = vcu_of(bx, G);
    volatile LAS unsigned* st = (volatile LAS unsigned*)(lds + LDS_ST_OFF);
    if (threadIdx.x < 2) st[threadIdx.x] = 0u;
    __syncthreads();
    const XcdBarrier bar = xcd_barrier_post((unsigned*)(A.ws + WS_CTL) + CW_BAR, st);
#if defined(MK_CG_SYNC)
    cg::grid_group grid = cg::this_grid();
#define SEAM() grid.sync()
#else
#define SEAM() xcd_barrier(bar)
#endif
#ifndef REP_G1
#define REP_G1 1
#endif
#ifndef REP_G1S
#define REP_G1S 1
#endif
#ifndef REP_G2
#define REP_G2 1
#endif
#ifndef REP_G2S
#define REP_G2S 1
#endif
#ifndef REP_G3
#define REP_G3 1
#endif
#ifndef REP_G4
#define REP_G4 1
#endif
#ifndef REP_G4S
#define REP_G4S 1
#endif
#ifndef REP_P0
#define REP_P0 1
#endif
#ifndef REP_P2
#define REP_P2 1
#endif
#ifndef REP_P3
#define REP_P3 1
#endif
    for (int rep = 0; rep < REP_P0; ++rep) phase_prologue(A, lds, vcu, G);
    SEAM();
#pragma unroll 1
    for (int pass_ = 0; pass_ < 2; ++pass_) { if ((pass_ == 0) == ((vcu & 1) == 0)) {
for (int rep_ = 0; rep_ < REP_G1; ++rep_) { pg8::Gemm g{(const bf16*)(A.ws + WS_XN), (const bf16*)(A.ws + WS_WIN), SEQ, DIN, DM}; pg8::StaticOrder S; S.init(SEQ, DIN, G, bx);
      pg8::EpiProj E{(bf16*)(A.ws + WS_PROJ), DIN, (bf16*)(A.ws + WS_QN), (bf16*)(A.ws + WS_KN), A.q_norm, A.k_norm, A.out + O_PK, A.out + O_PV, (LAS float*)(lds + 135168)}; pg8::gemm_phase<pg8::EpiProj, pg8::StaticOrder, true, true>(lds, g, S, E); }
    } else {
for (int rep_ = 0; rep_ < REP_G1S; ++rep_) for (int t = vcu; t < 256; t += G) skinny2<4, 6, 128, 3, DM / 128>((const bf16*)(A.ws + WS_XN) + (size_t)SEQ * DM, (const bf16*)(A.ws + WS_WIN), t, lds, SkProj{(bf16*)(A.ws + WS_PROJ)});
    } }
    SEAM();
    for (int rep = 0; rep < REP_P3; ++rep) phase_attn(A, lds, vcu, G);
    SEAM();
#pragma unroll 1
    for (int pass_ = 0; pass_ < 2; ++pass_) { if ((pass_ == 0) == ((vcu & 1) == 0)) {
for (int rep_ = 0; rep_ < REP_G2; ++rep_) { pg8::Gemm g{(const bf16*)(A.ws + WS_MIX), (const bf16*)(A.ws + WS_WOUT), SEQ, DM, DM}; pg8::StaticOrder S; S.init(SEQ, DM, G, bx);
      pg8::EpiRes1 E{A.x_prompt, (bf16*)(A.ws + WS_XN2), (float*)(A.ws + WS_SSQ), lds}; pg8::gemm_phase<pg8::EpiRes1, pg8::StaticOrder, true, true>(lds, g, S, E); }
    } else {
for (int rep_ = 0; rep_ < REP_G2S; ++rep_) for (int t = vcu; t < 256; t += G) skinny2<2, 4, 128, 4, DM / 128>((const bf16*)(A.ws + WS_MIX) + (size_t)SEQ * DM, (const bf16*)(A.ws + WS_WOUT), t, lds, SkRes1{A.x_sample, (bf16*)(A.ws + WS_XN2), (float*)(A.ws + WS_SSQ)});
    } }
    SEAM();
for (int rep_ = 0; rep_ < REP_G3; ++rep_) { pg8::Gemm g{(const bf16*)(A.ws + WS_XN2), (const bf16*)(A.ws + WS_WGU), MT, NGU, DM}; pg8::StaticOrder S; S.init(MT, NGU, G, bx);
      pg8::EpiSwiGLU E{(const float*)(A.ws + WS_SSQ), (bf16*)(A.ws + WS_H)}; pg8::gemm_phase<pg8::EpiSwiGLU, pg8::StaticOrder, true, true>(lds, g, S, E); }
    { constexpr int NU3 = (MT / 256) * (NGU / 256); const int full = NU3 % G;
      if (full != 0 && bx >= full) convert_wdown(A, lds, bx - full, G - full); else if (full == 0) convert_wdown(A, lds, bx, G); }
    SEAM();
#pragma unroll 1
    for (int pass_ = 0; pass_ < 2; ++pass_) { if ((pass_ == 0) == ((vcu & 1) == 0)) {
for (int rep_ = 0; rep_ < REP_G4; ++rep_) { pg8::Gemm g{(const bf16*)(A.ws + WS_H), (const bf16*)(A.ws + WS_WDN), SEQ, DM, DFF}; pg8::StaticOrder S; S.init(SEQ, DM, G, bx);
      pg8::EpiOut E{(const bf16*)(A.ws + WS_XN2), A.out + O_Y, lds}; pg8::gemm_phase<pg8::EpiOut, pg8::StaticOrder, true, true>(lds, g, S, E); }
    } else {
for (int rep_ = 0; rep_ < REP_G4S; ++rep_) for (int t = vcu; t < 256; t += G) skinny2<2, 4, 128, 4, DFF / 128>((const bf16*)(A.ws + WS_H) + (size_t)SEQ * DFF, (const bf16*)(A.ws + WS_WDN), t, lds, SkOut{(const bf16*)(A.ws + WS_XN2), A.out + O_Y});
    } }
}

extern "C" void kernel_launch(void* const* d_in, const int* in_sizes, int n_in, void* d_out, int out_size, void* d_ws, size_t ws_size, hipStream_t stream) {
    static int grid = 0;
    if (grid == 0) {
        if (n_in != 16 || (size_t)out_size != O_END || ws_size < WS_END) { fprintf(stderr, "kernel_launch: unexpected shapes: n_in %d out %d ws %zu\n", n_in, out_size, ws_size); grid = -1; return; }
        int dev = 0, cus = 0, per_cu = 0;
        if (hipGetDevice(&dev) != hipSuccess || hipDeviceGetAttribute(&cus, hipDeviceAttributeMultiprocessorCount, dev) != hipSuccess) { grid = -1; return; }
        if (hipFuncSetAttribute((const void*)fwd_mega, hipFuncAttributeMaxDynamicSharedMemorySize, LDS_BYTES) != hipSuccess) { fprintf(stderr, "kernel_launch: hipFuncSetAttribute failed\n"); grid = -1; return; }
        if (hipOccupancyMaxActiveBlocksPerMultiprocessor(&per_cu, (const void*)fwd_mega, NTHR, LDS_BYTES) != hipSuccess || per_cu < 1) { fprintf(stderr, "kernel_launch: occupancy query failed (%d)\n", per_cu); (void)hipGetLastError(); per_cu = 1; }
        if (per_cu > 1) per_cu = 1;
        grid = cus * per_cu;
    }
    if (grid < 0) return;
    Args a{};
    a.x_prompt = (const float*)d_in[0]; a.x_sample = (const float*)d_in[1]; a.cache_k = (const float*)d_in[2]; a.cache_v = (const float*)d_in[3]; a.state_conv = (const float*)d_in[4]; a.norm_mix = (const float*)d_in[5];
    a.w_in = (const float*)d_in[6]; a.conv_w = (const float*)d_in[7]; a.q_norm = (const float*)d_in[8]; a.k_norm = (const float*)d_in[9]; a.rel_bias = (const float*)d_in[10]; a.w_out = (const float*)d_in[11];
    a.norm_ffn = (const float*)d_in[12]; a.w_gate = (const float*)d_in[13]; a.w_up = (const float*)d_in[14]; a.w_down = (const float*)d_in[15];
    a.out = (float*)d_out; a.ws = (unsigned char*)d_ws;
    if (hipMemsetAsync((char*)d_ws + WS_CTL, 0, CTL_ZERO_BYTES, stream) != hipSuccess) { fprintf(stderr, "kernel_launch: memset of the control words failed\n"); return; }
    void* args[] = {&a};
    hipError_t e = hipLaunchCooperativeKernel((const void*)fwd_mega, dim3(grid), dim3(NTHR), args, LDS_BYTES, stream);
    if (e != hipSuccess) fprintf(stderr, "kernel_launch: cooperative launch failed: %s (grid %d)\n", hipGetErrorString(e), grid);
}
```

```cpp
#include <hip/hip_runtime.h>
#include <hip/hip_cooperative_groups.h>
#include <cstdio>
#include <cstdint>

constexpr int DM = 2048, SEQ = 8192, DBATCH = 32, DSEQ = 8, NSAMP = DBATCH * DSEQ, MT = SEQ + NSAMP;
constexpr int HD = 128, NH = 8, DATT = 1024, DCONV = 1024, DFF = 5632, DIN = 6144, WBUF = 2048, NGU = 2 * DFF;
constexpr float EPS = 1e-6f;
constexpr float LOG2E = 1.4426950408889634f;
constexpr float QSCALE = 0.08838834764831845f * LOG2E;

__device__ const unsigned char BUCKET[3][132] __attribute__((aligned(16))) = {
{0,1,2,3,4,5,6,7,8,9,10,11,12,13,14,15,16,16,16,16,16,16,17,17,17,17,17,17,17,17,18,18,18,18,18,18,18,18,18,18,19,19,19,19,19,19,19,19,19,19,19,19,19,19,20,20,20,20,20,20,20,20,20,20,20,20,20,20,20,20,20,20,20,21,21,21,21,21,21,21,21,21,21,21,21,21,21,21,21,21,21,21,21,21,21,21,21,21,21,22,22,22,22,22,22,22,22,22,22,22,22,22,22,22,22,22,22,22,22,22,22,22,22,22,22,22,22,22,22,0,0,0},
{0,4,8,12,16,16,17,17,18,18,19,19,19,19,20,20,20,20,20,21,21,21,21,21,21,22,22,22,22,22,22,22,22,22,23,23,23,23,23,23,23,23,23,23,23,23,24,24,24,24,24,24,24,24,24,24,24,24,24,24,24,24,25,25,25,25,25,25,25,25,25,25,25,25,25,25,25,25,25,25,25,25,25,26,26,26,26,26,26,26,26,26,26,26,26,26,26,26,26,26,26,26,26,26,26,26,26,26,26,26,26,26,26,27,27,27,27,27,27,27,27,27,27,27,27,27,27,27,27,0,0,0},
{0,16,18,19,20,21,21,22,22,23,23,23,24,24,24,24,25,25,25,25,25,26,26,26,26,26,26,26,26,27,27,27,27,27,27,27,27,27,27,28,28,28,28,28,28,28,28,28,28,28,28,28,29,29,29,29,29,29,29,29,29,29,29,29,29,29,29,29,29,29,30,30,30,30,30,30,30,30,30,30,30,30,30,30,30,30,30,30,30,30,30,30,30,30,30,31,31,31,31,31,31,31,31,31,31,31,31,31,31,31,31,31,31,31,31,31,31,31,31,31,31,31,31,31,31,31,31,31,31,0,0,0}};

#ifndef REP_E1
#define REP_E1 1
#endif
#ifndef REP_E2
#define REP_E2 1
#endif
#ifndef REP_E3
#define REP_E3 1
#endif
#ifndef REP_E4
#define REP_E4 1
#endif
namespace pg8 {
#define PG8_LAS __attribute__((address_space(3)))
typedef unsigned short bf16_t;
typedef short bf16x8 __attribute__((ext_vector_type(8)));
typedef float f32x4 __attribute__((ext_vector_type(4)));
typedef unsigned u32x4 __attribute__((ext_vector_type(4)));
typedef unsigned u32x2 __attribute__((ext_vector_type(2)));
constexpr int BM = 256, BK = 64, HALF = 128, HTB = HALF * BK * 2  , STAGE_BYTES = 8 * HTB, NXCD = 8, WGM = 8;

__host__ __device__ __forceinline__ int lds_byte(int r, int c) { const int st = (r >> 4) * 2 + (c >> 5), rr = r & 15, cc = c & 31, ob = rr * 64 + cc * 2; return st * 1024 + (ob ^ (((ob >> 9) & 1) << 5)); }
__host__ __device__ __forceinline__ void stage_rc(int b, int& R, int& C) { const int st = b / 1024, sb = b % 1024, swz = sb ^ (((sb >> 9) & 1) << 5); R = (st >> 1) * 16 + swz / 64; C = (st & 1) * 32 + (swz % 64) / 2; }
__host__ __device__ __forceinline__ int perm32(int rho) { const int n = rho >> 4, i = rho & 15; return 8 * (i >> 2) + 4 * n + (i & 3); }

struct Unit { int pm, pn; };
struct Gemm { const bf16_t* A; const bf16_t* Bt; int M, N, K; };

struct StaticOrder {
    int nM, nN, nwg, G, c;
    __host__ __device__ void init(int M, int N, int G_, int c_) { nM = M / BM; nN = N / BM; nwg = nM * nN; G = G_; c = c_; }
    __host__ __device__ bool next(int i, Unit& u) const {
        const long L = (long)i * G + c; if (L >= nwg) return false;
        int wgid = (int)L; { const int q = nwg / NXCD, r = nwg % NXCD, xcd = wgid % NXCD, off = wgid / NXCD; wgid = (xcd < r ? xcd * (q + 1) : r * (q + 1) + (xcd - r) * q) + off; }
        const int nig = WGM * nN, gid = wgid / nig, fm = gid * WGM, gsz = (nM - fm) < WGM ? (nM - fm) : WGM;
        u.pm = fm + ((wgid % nig) % gsz); u.pn = (wgid % nig) / gsz; return true;
    }
    __device__ __forceinline__ void a_ready(const Unit&) const {}
    __device__ __forceinline__ void done(const Unit&) const {}
};

__device__ __forceinline__ unsigned cvt_pk_bf16(float lo, float hi) { unsigned r; asm volatile("v_cvt_pk_bf16_f32 %0, %1, %2" : "=v"(r) : "v"(lo), "v"(hi)); return r; }

struct EpiProj {
    static constexpr int REPS = REP_E1; static constexpr bool PERM = true, AFTER_DRAIN = false;
    bf16_t* O; int ldc; bf16_t* QN; bf16_t* KN; const float* gq; const float* gk; float* out_k; float* out_v; PG8_LAS float* xch;
    __device__ __forceinline__ void operator()(const f32x4 (&acc)[2][2][4][2], const Unit& u, int wr, int wc, int fr, int fq) const {
        const int row0 = u.pm * BM + wr * 64 + fr, col0 = u.pn * BM + wc * 32 + 8 * fq;
        const bool isq = u.pn >= 12 && u.pn < 16, isk = u.pn >= 16 && u.pn < 20, isv = u.pn >= 20;
        if (isq || isk) {
#pragma unroll
            for (int ai = 0; ai < 2; ++ai)
#pragma unroll
                for (int m = 0; m < 4; ++m)
#pragma unroll
                    for (int bj = 0; bj < 2; ++bj) { const f32x4 v0 = acc[ai][bj][m][0], v1 = acc[ai][bj][m][1];
                        float ss = ((v0[0] * v0[0] + v0[1] * v0[1]) + (v0[2] * v0[2] + v0[3] * v0[3])) + ((v1[0] * v1[0] + v1[1] * v1[1]) + (v1[2] * v1[2] + v1[3] * v1[3]));
                        ss += __shfl_xor(ss, 16); ss += __shfl_xor(ss, 32);
                        if (fq == 0) xch[((ai * HALF + wr * 64 + m * 16 + fr) * 2 + bj) * 4 + wc] = ss; }
        }
        asm volatile("s_waitcnt lgkmcnt(0)" ::: "memory"); __builtin_amdgcn_s_barrier(); asm volatile("" ::: "memory");
        if (isq || isk) {
            const float* g = isq ? gq : gk; const float gs = isq ? QSCALE : 1.0f; bf16_t* dst = isq ? QN : KN; const int hc0 = (u.pn - (isq ? 12 : 16)) * BM;
            f32x4 g0[2], g1[2];
#pragma unroll
            for (int bj = 0; bj < 2; ++bj) { g0[bj] = *(const f32x4*)(g + wc * 32 + 8 * fq) * gs; g1[bj] = *(const f32x4*)(g + wc * 32 + 8 * fq + 4) * gs; }
#pragma unroll
            for (int ai = 0; ai < 2; ++ai)
#pragma unroll
                for (int m = 0; m < 4; ++m) { const int r = row0 + ai * HALF + m * 16;
#pragma unroll
                    for (int bj = 0; bj < 2; ++bj) { const f32x4 p = *(const PG8_LAS f32x4*)(xch + ((ai * HALF + wr * 64 + m * 16 + fr) * 2 + bj) * 4);
                        const float rstd = 1.0f / sqrtf(((p[0] + p[1]) + (p[2] + p[3])) * (1.0f / 128.0f) + EPS);
                        const f32x4 v0 = acc[ai][bj][m][0] * rstd * g0[bj], v1 = acc[ai][bj][m][1] * rstd * g1[bj];
                        u32x4 w; w.x = cvt_pk_bf16(v0[0], v0[1]); w.y = cvt_pk_bf16(v0[2], v0[3]); w.z = cvt_pk_bf16(v1[0], v1[1]); w.w = cvt_pk_bf16(v1[2], v1[3]);
                        *(u32x4*)(dst + (size_t)r * 1024 + hc0 + bj * HALF + wc * 32 + 8 * fq) = w;
} }
        } else {
#pragma unroll
            for (int ai = 0; ai < 2; ++ai)
#pragma unroll
                for (int m = 0; m < 4; ++m) { const int r = row0 + ai * HALF + m * 16; bf16_t* rowp = O + (size_t)r * ldc + col0;
#pragma unroll
                    for (int bj = 0; bj < 2; ++bj) { const f32x4 v0 = acc[ai][bj][m][0], v1 = acc[ai][bj][m][1];
                        u32x4 w; w.x = cvt_pk_bf16(v0[0], v0[1]); w.y = cvt_pk_bf16(v0[2], v0[3]); w.z = cvt_pk_bf16(v1[0], v1[1]); w.w = cvt_pk_bf16(v1[2], v1[3]);
                        *(u32x4*)(rowp + bj * HALF) = w;
} }
        }
    }
};
struct EpiRes1 {
    static constexpr int REPS = REP_E2; static constexpr bool PERM = false, AFTER_DRAIN = false;
    const float* xp; bf16_t* X1b; float* SSQ;
    __device__ __forceinline__ void operator()(const f32x4 (&acc)[2][2][4][2], const Unit& u, int wr, int wc, int fr, int fq) const {
        const int row0 = u.pm * BM + wr * 64 + fr, col0 = u.pn * BM + wc * 32 + 4 * fq;
#pragma unroll
        for (int ai = 0; ai < 2; ++ai) {
            f32x4 xv[4][2][2];
#pragma unroll
            for (int m = 0; m < 4; ++m)
#pragma unroll
                for (int bj = 0; bj < 2; ++bj)
#pragma unroll
                    for (int n = 0; n < 2; ++n) xv[m][bj][n] = __builtin_nontemporal_load((const f32x4*)(xp + (size_t)(row0 + ai * HALF + m * 16) * DM + col0 + bj * HALF + n * 16));
            asm volatile("" ::: "memory");
#pragma unroll
            for (int m = 0; m < 4; ++m) { const int r = row0 + ai * HALF + m * 16; const size_t off = (size_t)r * DM + col0;
                float ss = 0.f;
#pragma unroll
                for (int bj = 0; bj < 2; ++bj)
#pragma unroll
                    for (int n = 0; n < 2; ++n) { const f32x4 o = xv[m][bj][n] + acc[ai][bj][m][n];
                        ss += (o[0] * o[0] + o[1] * o[1]) + (o[2] * o[2] + o[3] * o[3]);
                        u32x2 pk; pk.x = cvt_pk_bf16(o[0], o[1]); pk.y = cvt_pk_bf16(o[2], o[3]);
                        *(u32x2*)(X1b + off + bj * HALF + n * 16) = pk; }
                ss += __shfl_xor(ss, 16); ss += __shfl_xor(ss, 32);
                if (fq == 0) SSQ[(size_t)r * 32 + u.pn * 4 + wc] = ss; }
        }
    }
};
struct EpiSwiGLU {
    static constexpr int REPS = REP_E3; static constexpr bool PERM = false, AFTER_DRAIN = false;
    const float* SSQ; bf16_t* H;
    __device__ __forceinline__ void operator()(const f32x4 (&acc)[2][2][4][2], const Unit& u, int wr, int wc, int fr, int fq) const {
        const int row0 = u.pm * BM + wr * 64 + fr, col0 = u.pn * HALF + wc * 32 + 8 * fq;
#pragma unroll
        for (int ai = 0; ai < 2; ++ai)
#pragma unroll
            for (int m = 0; m < 4; ++m) { const int r = row0 + ai * HALF + m * 16;
                const f32x4* sp = (const f32x4*)(SSQ + (size_t)r * 32 + fq * 8); const f32x4 a = sp[0], b = sp[1];
                float s = ((a[0] + a[1]) + (a[2] + a[3])) + ((b[0] + b[1]) + (b[2] + b[3]));
                s += __shfl_xor(s, 16); s += __shfl_xor(s, 32);
                const float rstd = __builtin_amdgcn_rsqf(s * (1.0f / DM) + EPS);
                float hv[8];
#pragma unroll
                for (int n = 0; n < 2; ++n)
#pragma unroll
                    for (int j = 0; j < 4; ++j) { const float gt = acc[ai][0][m][n][j] * rstd, up = acc[ai][1][m][n][j] * rstd;
                        hv[n * 4 + j] = gt * up * __builtin_amdgcn_rcpf(1.0f + __expf(-gt)); }
                u32x4 w; w.x = cvt_pk_bf16(hv[0], hv[1]); w.y = cvt_pk_bf16(hv[2], hv[3]); w.z = cvt_pk_bf16(hv[4], hv[5]); w.w = cvt_pk_bf16(hv[6], hv[7]);
                *(u32x4*)(H + (size_t)r * DFF + col0) = w; }
    }
};
struct EpiOut {
    static constexpr int REPS = REP_E4; static constexpr bool PERM = false, AFTER_DRAIN = false;
    const bf16_t* X1b; float* out;
    __device__ __forceinline__ void operator()(const f32x4 (&acc)[2][2][4][2], const Unit& u, int wr, int wc, int fr, int fq) const {
        const int row0 = u.pm * BM + wr * 64 + fr, col0 = u.pn * BM + wc * 32 + 4 * fq;
        u32x2 xw[2][4][2][2];
#pragma unroll
        for (int ai = 0; ai < 2; ++ai)
#pragma unroll
            for (int m = 0; m < 4; ++m)
#pragma unroll
                for (int bj = 0; bj < 2; ++bj)
#pragma unroll
                    for (int n = 0; n < 2; ++n) xw[ai][m][bj][n] = *(const u32x2*)(X1b + (size_t)(row0 + ai * HALF + m * 16) * DM + col0 + bj * HALF + n * 16);
        asm volatile("" ::: "memory");
#pragma unroll
        for (int ai = 0; ai < 2; ++ai)
#pragma unroll
            for (int m = 0; m < 4; ++m) { const size_t off = (size_t)(row0 + ai * HALF + m * 16) * DM + col0;
#pragma unroll
                for (int bj = 0; bj < 2; ++bj)
#pragma unroll
                    for (int n = 0; n < 2; ++n) { const u32x2 w = xw[ai][m][bj][n];
                        const f32x4 xv = (f32x4){__builtin_bit_cast(float, w.x << 16), __builtin_bit_cast(float, w.x & 0xffff0000u), __builtin_bit_cast(float, w.y << 16), __builtin_bit_cast(float, w.y & 0xffff0000u)};
                        __builtin_nontemporal_store(xv + acc[ai][bj][m][n], (f32x4*)(out + off + bj * HALF + n * 16)); } }
    }
};

template <class Epi, class Sched, bool ALIGN_EPI = false, bool SP2 = false>
__device__ __forceinline__ void gemm_phase(PG8_LAS unsigned char* lds, const Gemm g, const Sched& S, const Epi& E) {
    int tid_ = threadIdx.x; asm volatile("" : "+v"(tid_));
    const int tid = tid_, wid = __builtin_amdgcn_readfirstlane(tid >> 6), lane = tid & 63, wr = wid >> 2, wc = wid & 3, fr = lane & 15, fq = lane >> 4;
    const int K = g.K, nt = K / BK;
    unsigned voffA[2], voffB[2];
#pragma unroll
    for (int i = 0; i < 2; ++i) { int R, C; stage_rc(tid * 16 + i * 8192, R, C); const int Rb = Epi::PERM ? ((R & ~31) + perm32(R & 31)) : R;
        voffA[i] = (unsigned)(R * K + C) * 2u; voffB[i] = (unsigned)(Rb * K + C) * 2u; }
    const size_t kstep = (size_t)(BK * 2);
    const size_t hstep = (size_t)HALF * K * 2;
    const size_t tstep = 2 * hstep;
    const unsigned ldsw = (unsigned)wid * 1024u;
    const int aoff = lds_byte(wr * 64 + fr, fq * 8), boff = lds_byte(wc * 32 + fr, fq * 8);
#define PG8_SA(b, h) (((b) * 2 + (h)) * HTB)
#define PG8_SB(b, h) ((4 + (b) * 2 + (h)) * HTB)
#define PG8_STAGE(bufoff, gbase, voff) do { _Pragma("unroll") for (int _i = 0; _i < 2; ++_i) \
        __builtin_amdgcn_global_load_lds((const unsigned*)((const char*)(gbase) + (voff)[_i]), (PG8_LAS unsigned*)(lds + (bufoff) + ldsw + _i * 8192), 16, 0, 0); } while (0)
#define PG8_LDA(dst, b, h) do { _Pragma("unroll") for (int m = 0; m < 4; ++m) _Pragma("unroll") for (int k = 0; k < 2; ++k) dst[m][k] = *(const PG8_LAS bf16x8*)(lds + PG8_SA(b, h) + aoff + m * 2048 + k * 1024); } while (0)
#define PG8_LDB(dst, b, h) do { _Pragma("unroll") for (int n = 0; n < 2; ++n) _Pragma("unroll") for (int k = 0; k < 2; ++k) dst[n][k] = *(const PG8_LAS bf16x8*)(lds + PG8_SB(b, h) + boff + n * 2048 + k * 1024); } while (0)
#define PG8_MMA(ai, bj, At, Bt) do { __builtin_amdgcn_s_setprio(1); _Pragma("unroll") for (int m = 0; m < 4; ++m) _Pragma("unroll") for (int n = 0; n < 2; ++n) _Pragma("unroll") for (int k = 0; k < 2; ++k) \
        acc[ai][bj][m][n] = __builtin_amdgcn_mfma_f32_16x16x32_bf16(Bt[n][k], At[m][k], acc[ai][bj][m][n], 0, 0, 0); __builtin_amdgcn_s_setprio(0); } while (0)
#define PG8_WAIT_V(n) asm volatile("s_waitcnt vmcnt(" #n ")" ::: "memory")
#define PG8_WAIT_L(n) asm volatile("s_waitcnt lgkmcnt(" #n ")" ::: "memory")
#define PG8_BAR __builtin_amdgcn_s_barrier()
#define PG8_SCHED __builtin_amdgcn_sched_barrier(0)
    Unit cur, nxt; int ui = 0;
    if (!S.next(0, cur)) return;
    f32x4 acc[2][2][4][2];
#pragma unroll
    for (int a = 0; a < 2; ++a)
#pragma unroll
        for (int b = 0; b < 2; ++b)
#pragma unroll
            for (int m = 0; m < 4; ++m)
#pragma unroll
                for (int n = 0; n < 2; ++n) acc[a][b][m][n] = (f32x4){0.f, 0.f, 0.f, 0.f};
    bf16x8 At[4][2], B0[2][2], B1[2][2];
    const char* cA = (const char*)g.A + (size_t)cur.pm * tstep; const char* cB = (const char*)g.Bt + (size_t)cur.pn * tstep;
    S.a_ready(cur);
    if constexpr (SP2) {
        PG8_STAGE(PG8_SB(0, 0), cB, voffB); PG8_STAGE(PG8_SB(0, 1), cB + hstep, voffB); PG8_STAGE(PG8_SA(0, 0), cA, voffA); PG8_STAGE(PG8_SA(0, 1), cA + hstep, voffA);
        if (wr == 1) PG8_BAR;
        PG8_WAIT_V(2); PG8_BAR;
        PG8_STAGE(PG8_SB(1, 0), cB + kstep, voffB); PG8_STAGE(PG8_SA(1, 0), cA + kstep, voffA); PG8_STAGE(PG8_SB(1, 1), cB + hstep + kstep, voffB);
        PG8_WAIT_V(6); PG8_BAR;
    } else {
        PG8_STAGE(PG8_SB(0, 0), cB, voffB); PG8_STAGE(PG8_SA(0, 0), cA, voffA); PG8_STAGE(PG8_SB(0, 1), cB + hstep, voffB); PG8_STAGE(PG8_SA(0, 1), cA + hstep, voffA);
        if (wr == 1) PG8_BAR;
        PG8_WAIT_V(4); PG8_BAR;
        PG8_STAGE(PG8_SB(1, 0), cB + kstep, voffB); PG8_STAGE(PG8_SA(1, 0), cA + kstep, voffA); PG8_STAGE(PG8_SB(1, 1), cB + hstep + kstep, voffB);
        PG8_WAIT_V(6); PG8_BAR;
    }
    for (;;) {
        const bool has_next = S.next(ui + 1, nxt);
        const char* nA = has_next ? (const char*)g.A + (size_t)nxt.pm * tstep : cA; const char* nB = has_next ? (const char*)g.Bt + (size_t)nxt.pn * tstep : cB;
        for (int t = 0; t < nt; t += 2) {
            const bool last = (t == nt - 2);
            const char* a1 = cA + (size_t)(t + 1) * kstep;
            const char* a2 = last ? nA : cA + (size_t)(t + 2) * kstep; const char* b2 = last ? nB : cB + (size_t)(t + 2) * kstep;
            const char* a3 = a2 + kstep; const char* b3 = b2 + kstep;
            if (last && has_next) S.a_ready(nxt);
            if constexpr (SP2) {
            PG8_LDB(B0, 0, 0); PG8_LDB(B1, 0, 1); PG8_SCHED; PG8_LDA(At, 0, 0); PG8_STAGE(PG8_SA(1, 1), a1 + hstep, voffA);
            PG8_WAIT_V(8); PG8_WAIT_L(0); PG8_BAR; PG8_MMA(0, 0, At, B0); PG8_MMA(0, 1, At, B1); PG8_BAR; PG8_SCHED;
            PG8_LDA(At, 0, 1); PG8_STAGE(PG8_SB(0, 0), b2, voffB); PG8_STAGE(PG8_SB(0, 1), b2 + hstep, voffB); PG8_STAGE(PG8_SA(0, 0), a2, voffA);
            PG8_WAIT_V(8); PG8_WAIT_L(0); PG8_BAR; PG8_MMA(1, 0, At, B0); PG8_MMA(1, 1, At, B1); PG8_BAR; PG8_SCHED;
            PG8_LDB(B0, 1, 0); PG8_LDB(B1, 1, 1); PG8_SCHED; PG8_LDA(At, 1, 0); PG8_STAGE(PG8_SA(0, 1), a2 + hstep, voffA);
            PG8_WAIT_V(8); PG8_WAIT_L(0); PG8_BAR; PG8_MMA(0, 0, At, B0); PG8_MMA(0, 1, At, B1); PG8_BAR; PG8_SCHED;
            PG8_LDA(At, 1, 1); PG8_STAGE(PG8_SB(1, 0), b3, voffB); PG8_STAGE(PG8_SB(1, 1), b3 + hstep, voffB); PG8_STAGE(PG8_SA(1, 0), a3, voffA);
            PG8_WAIT_V(8); PG8_WAIT_L(0); PG8_BAR; PG8_MMA(1, 0, At, B0); PG8_MMA(1, 1, At, B1); PG8_BAR; PG8_SCHED;
            } else {
            PG8_LDB(B0, 0, 0); PG8_SCHED; PG8_LDA(At, 0, 0); PG8_STAGE(PG8_SA(1, 1), a1 + hstep, voffA);
            PG8_WAIT_L(8); PG8_BAR; PG8_WAIT_L(0); PG8_MMA(0, 0, At, B0); PG8_BAR; PG8_SCHED;
            PG8_LDB(B1, 0, 1); PG8_STAGE(PG8_SB(0, 0), b2, voffB);
            PG8_BAR; PG8_WAIT_L(0); PG8_MMA(0, 1, At, B1); PG8_BAR;
            PG8_LDA(At, 0, 1); PG8_STAGE(PG8_SA(0, 0), a2, voffA);
            PG8_BAR; PG8_WAIT_L(0); PG8_MMA(1, 0, At, B0); PG8_BAR; PG8_SCHED;
            PG8_STAGE(PG8_SB(0, 1), b2 + hstep, voffB);
            PG8_WAIT_V(6); PG8_BAR; PG8_MMA(1, 1, At, B1); PG8_BAR;
            PG8_LDB(B0, 1, 0); PG8_SCHED; PG8_LDA(At, 1, 0); PG8_STAGE(PG8_SA(0, 1), a2 + hstep, voffA);
            PG8_WAIT_L(8); PG8_BAR; PG8_WAIT_L(0); PG8_MMA(0, 0, At, B0); PG8_BAR; PG8_SCHED;
            PG8_LDB(B1, 1, 1); PG8_STAGE(PG8_SB(1, 0), b3, voffB);
            PG8_BAR; PG8_WAIT_L(0); PG8_MMA(0, 1, At, B1); PG8_BAR;
            PG8_LDA(At, 1, 1); PG8_STAGE(PG8_SA(1, 0), a3, voffA);
            PG8_BAR; PG8_WAIT_L(0); PG8_MMA(1, 0, At, B0); PG8_BAR; PG8_SCHED;
            PG8_STAGE(PG8_SB(1, 1), b3 + hstep, voffB);
            PG8_WAIT_V(6); PG8_BAR; PG8_MMA(1, 1, At, B1); PG8_BAR;
            }
        }
        if constexpr (ALIGN_EPI) { if (wr == 0) PG8_BAR; }
        if constexpr (!Epi::AFTER_DRAIN) { E(acc, cur, wr, wc, fr, fq); if constexpr (Epi::REPS > 1) { asm volatile("" ::: "memory"); Unit c2 = cur; int fr2 = fr, fq2 = fq; asm volatile("" : "+s"(c2.pm), "+s"(c2.pn), "+v"(fr2), "+v"(fq2)); E(acc, c2, wr, wc, fr2, fq2); } S.done(cur); }
        if (!has_next) break;
#pragma unroll
        for (int a = 0; a < 2; ++a)
#pragma unroll
            for (int b = 0; b < 2; ++b)
#pragma unroll
                for (int m = 0; m < 4; ++m)
#pragma unroll
                    for (int n = 0; n < 2; ++n) acc[a][b][m][n] = (f32x4){0.f, 0.f, 0.f, 0.f};
        cur = nxt; cA = nA; cB = nB; ++ui;
        if constexpr (ALIGN_EPI) { if (wr == 1) PG8_BAR; }
    }
    PG8_WAIT_V(0);
    if constexpr (!ALIGN_EPI) { if (wr == 0) PG8_BAR; }
    PG8_BAR;
#undef PG8_SA
#undef PG8_SB
#undef PG8_STAGE
#undef PG8_LDA
#undef PG8_LDB
#undef PG8_MMA
#undef PG8_WAIT_V
#undef PG8_WAIT_L
#undef PG8_BAR
#undef PG8_SCHED
}
}

#define GAS __attribute__((address_space(1)))
#define LAS __attribute__((address_space(3)))
typedef unsigned short bf16;
typedef unsigned v4u __attribute__((ext_vector_type(4)));
typedef unsigned v2u __attribute__((ext_vector_type(2)));
typedef float f32x4 __attribute__((ext_vector_type(4)));
typedef float f32x2 __attribute__((ext_vector_type(2)));
#define LDS_WAIT() asm volatile("s_waitcnt lgkmcnt(0)" ::: "memory")
constexpr int NWAVES = 8, NTHR = 512;
constexpr int LDS_BYTES = 160 * 1024;
constexpr int LDS_ST_OFF = LDS_BYTES - 64;

__device__ __forceinline__ int opaque_tid() { int t = threadIdx.x; asm volatile("" : "+v"(t)); return t; }
__device__ __forceinline__ unsigned f2bf(float f) { unsigned u = __builtin_bit_cast(unsigned, f); return (u + 0x7fffu + ((u >> 16) & 1u)) >> 16; }
__device__ __forceinline__ unsigned pk2(float lo, float hi) { unsigned r; asm volatile("v_cvt_pk_bf16_f32 %0, %1, %2" : "=v"(r) : "v"(lo), "v"(hi)); return r; }
__device__ __forceinline__ float bf_lo(unsigned w) { return __builtin_bit_cast(float, w << 16); }
__device__ __forceinline__ float bf_hi(unsigned w) { return __builtin_bit_cast(float, w & 0xffff0000u); }
__device__ __forceinline__ float wave_sum(float v) {
#pragma unroll
    for (int o = 1; o < 64; o <<= 1) v += __shfl_xor(v, o);
    return v;
}
__device__ __forceinline__ float wave_max(float v) {
#pragma unroll
    for (int o = 1; o < 64; o <<= 1) v = fmaxf(v, __shfl_xor(v, o));
    return v;
}

constexpr size_t MiB = 1u << 20;
constexpr size_t WS_CTL = 0;
constexpr size_t WS_WIN = 1 * MiB;
constexpr size_t WS_WOUT = 25 * MiB;
constexpr size_t WS_WGU = 33 * MiB;
constexpr size_t WS_WDN = 77 * MiB;
constexpr size_t WS_XN = 99 * MiB;
constexpr size_t WS_PROJ = 132 * MiB;
constexpr size_t WS_QN = 231 * MiB;
constexpr size_t WS_KN = 248 * MiB;
constexpr size_t WS_VT1 = 265 * MiB, WS_VT2 = 281 * MiB, WS_VT3 = 297 * MiB;
constexpr size_t WS_MIX = 313 * MiB;
constexpr size_t WS_X1 = 346 * MiB;
constexpr size_t WS_XN2 = 412 * MiB;
constexpr size_t WS_SSQ = 445 * MiB;
constexpr size_t WS_H = 447 * MiB;
constexpr size_t WS_END = 538 * MiB;

constexpr size_t O_Y = 0;
constexpr size_t O_PK = (size_t)MT * DM;
constexpr size_t O_PV = O_PK + (size_t)2048 * 1024;
constexpr size_t O_PC = O_PV + (size_t)2048 * 1024;
constexpr size_t O_SK = O_PC + 2048;
constexpr size_t O_SV = O_SK + (size_t)NSAMP * 1024;
constexpr size_t O_SC = O_SV + (size_t)NSAMP * 1024;
constexpr size_t O_END = O_SC + (size_t)DBATCH * 2 * 1024;

struct Args {
    const float* x_prompt; const float* x_sample; const float* cache_k; const float* cache_v; const float* state_conv; const float* norm_mix; const float* w_in; const float* conv_w;
    const float* q_norm; const float* k_norm; const float* rel_bias; const float* w_out; const float* norm_ffn; const float* w_gate; const float* w_up; const float* w_down;
    float* out; unsigned char* ws;
};

__device__ __forceinline__ void p0_transpose_item(const float* W, int N, int K, int c0, int k0, bf16* WT, int drow0, bool perm, LAS float* scr, int lane, const float* kscale = nullptr) {
    const int ksub = lane >> 4, n4 = lane & 15;
    f32x4 v[16];
    const GAS f32x4* src = (const GAS f32x4*)(W + (size_t)(k0 + ksub) * N + c0 + 4 * n4);
#pragma unroll
    for (int i = 0; i < 16; ++i) v[i] = __builtin_nontemporal_load(src + (size_t)i * N);
    if (kscale) {
#pragma unroll
        for (int i = 0; i < 16; ++i) v[i] = v[i] * kscale[k0 + 4 * i + ksub]; }
#pragma unroll
    for (int i = 0; i < 16; ++i) { LAS float* d = scr + (4 * i + ksub) * 65 + 4 * n4; d[0] = v[i][0]; d[1] = v[i][1]; d[2] = v[i][2]; d[3] = v[i][3]; }
    LDS_WAIT(); asm volatile("" ::: "memory");
    const int c = lane >> 3, nsub = lane & 7;
#pragma unroll
    for (int j = 0; j < 8; ++j) { const int n = nsub + 8 * j; const int ns = perm ? ((n & 32) + pg8::perm32(n & 31)) : n; const LAS float* s = scr + (8 * c) * 65 + ns;
        v4u o; o.x = pk2(s[0 * 65], s[1 * 65]); o.y = pk2(s[2 * 65], s[3 * 65]); o.z = pk2(s[4 * 65], s[5 * 65]); o.w = pk2(s[6 * 65], s[7 * 65]);
        *(GAS v4u*)(WT + (size_t)(drow0 + n) * K + k0 + 8 * c) = o; }
    LDS_WAIT(); asm volatile("" ::: "memory");
}
__device__ __forceinline__ void p0_rms_row(const float* xrow, const float* g, bf16* orow, int lane) {
    const GAS f32x4* xr = (const GAS f32x4*)xrow + lane; const GAS f32x4* gr = (const GAS f32x4*)g + lane;
    f32x4 v[8]; float s = 0.f;
#pragma unroll
    for (int j = 0; j < 8; ++j) { v[j] = __builtin_nontemporal_load(xr + 64 * j); s += (v[j].x * v[j].x + v[j].y * v[j].y) + (v[j].z * v[j].z + v[j].w * v[j].w); }
    const float rstd = 1.0f / sqrtf(wave_sum(s) * (1.f / DM) + EPS);
    GAS v2u* o8 = (GAS v2u*)orow + lane;
#pragma unroll
    for (int j = 0; j < 8; ++j) { const f32x4 gg = gr[64 * j]; v2u o; o.x = pk2(v[j].x * rstd * gg.x, v[j].y * rstd * gg.y); o.y = pk2(v[j].z * rstd * gg.z, v[j].w * rstd * gg.w); o8[64 * j] = o; }
}
__device__ __forceinline__ void phase_prologue(const Args& A, LAS unsigned char* lds, int vcu, int G) {
    const int tid = opaque_tid(), lane = tid & 63, wave = __builtin_amdgcn_readfirstlane(tid >> 6);
    LAS float* scr = (LAS float*)(lds + wave * 17408);
    const int gw = vcu * NWAVES + wave, NGW = G * NWAVES;
    bf16* WIN = (bf16*)(A.ws + WS_WIN); bf16* WOUT = (bf16*)(A.ws + WS_WOUT); bf16* WGU = (bf16*)(A.ws + WS_WGU); bf16* WDN = (bf16*)(A.ws + WS_WDN); bf16* XN = (bf16*)(A.ws + WS_XN);
    constexpr int I_IN = (DM / 64) * (DIN / 64), I_OUT = (DM / 64) * (DM / 64), I_GU = (DM / 64) * (NGU / 64), I_DN = (DFF / 64) * (DM / 64);
    constexpr int NITEMS = I_IN;
    for (int it = gw; it < NITEMS; it += NGW) { const int nb = it % (DIN / 64), kb = it / (DIN / 64); p0_transpose_item(A.w_in, DIN, DM, 64 * nb, 64 * kb, WIN, 64 * nb, false, scr, lane); }
    for (int m = gw; m < MT; m += NGW) p0_rms_row(m < SEQ ? A.x_prompt + (size_t)m * DM : A.x_sample + (size_t)(m - SEQ) * DM, A.norm_mix, XN + (size_t)m * DM, lane);
}
constexpr int PL_WO = (DM / 64) * (DM / 64) / 8, PL_GU = PL_WO + (DM / 64) * (NGU / 64) / 8;
__device__ __forceinline__ void convert_gu_item(const Args& A, LAS unsigned char* lds, int item) {
    const int tid = opaque_tid(), lane = tid & 63, wave = __builtin_amdgcn_readfirstlane(tid >> 6);
    LAS float* scr = (LAS float*)(lds + wave * 17408);
    bf16* WGU = (bf16*)(A.ws + WS_WGU);
    if (item < PL_WO) { const int r = item * 8 + wave; const int nb = r % (DM / 64), kb = r / (DM / 64); p0_transpose_item(A.w_out, DM, DM, 64 * nb, 64 * kb, (bf16*)(A.ws + WS_WOUT), 64 * nb, false, scr, lane); return; }
    item -= PL_WO;
    { const int r = item * 8 + wave; const int nb = r % (NGU / 64), kb = r / (NGU / 64);
        const int pn = nb >> 2, t = (nb >> 1) & 1, w2 = nb & 1; p0_transpose_item(t ? A.w_up : A.w_gate, DFF, DM, 128 * pn + 64 * w2, 64 * kb, WGU, 64 * nb, true, scr, lane, A.norm_ffn); }
}
__device__ __forceinline__ void convert_wdown(const Args& A, LAS unsigned char* lds, int widx, int nw) {
    const int tid = opaque_tid(), lane = tid & 63, wave = __builtin_amdgcn_readfirstlane(tid >> 6);
    LAS float* scr = (LAS float*)(lds + wave * 17408);
    bf16* WDN = (bf16*)(A.ws + WS_WDN);
    constexpr int I_DN = (DFF / 64) * (DM / 64);
    for (int r = widx * NWAVES + wave; r < I_DN; r += nw * NWAVES) { const int nb = r % (DM / 64), kb = r / (DM / 64); p0_transpose_item(A.w_down, DM, DFF, 64 * nb, 64 * kb, WDN, 64 * nb, false, scr, lane); }
}

__device__ __forceinline__ void unpack8(const v4u w, float* f) { f[0] = bf_lo(w.x); f[1] = bf_hi(w.x); f[2] = bf_lo(w.y); f[3] = bf_hi(w.y); f[4] = bf_lo(w.z); f[5] = bf_hi(w.z); f[6] = bf_lo(w.w); f[7] = bf_hi(w.w); }
__device__ __forceinline__ float softmax_bound_l2(const Args& A, int lane) {
    float mq = fmaxf(fabsf(A.q_norm[lane]), fabsf(A.q_norm[lane + 64])), mk = fmaxf(fabsf(A.k_norm[lane]), fabsf(A.k_norm[lane + 64]));
    float mb = fmaxf(fmaxf(fabsf(A.rel_bias[lane]), fabsf(A.rel_bias[lane + 64])), fmaxf(fabsf(A.rel_bias[lane + 128]), fabsf(A.rel_bias[lane + 192])));
    mq = wave_max(mq); mk = wave_max(mk); mb = wave_max(mb);
    return LOG2E * (11.313708498984761f * mq * mk * 1.01f + mb);
}
typedef short bf16x8 __attribute__((ext_vector_type(8)));
__device__ __forceinline__ bf16x8 ld16(const bf16* p) { return __builtin_bit_cast(bf16x8, *(const GAS v4u*)p); }
typedef short s16x4 __attribute__((ext_vector_type(4)));
constexpr int AT_STAGE = 65536, AT_VOFF = 32768, AT_TBL = 131072;
__device__ __forceinline__ int swz_f(int row) { return (((row ^ (row >> 2) ^ (row >> 4)) & 1) << 1) | ((((row >> 1) ^ (row >> 5)) & 1) << 2) | ((((row >> 3) ^ (row >> 6)) & 1) << 3); }
__device__ __forceinline__ void attn2_stage(LAS unsigned char* lds, int buf, const bf16* Kg, const bf16* Vg, int P0, int wave, int lane) {
#pragma unroll
    for (int i = 0; i < 4; ++i) { const int row = (wave * 4 + i) * 4 + (lane >> 4), c = (lane & 15) ^ swz_f(row);
        __builtin_amdgcn_global_load_lds((const unsigned*)(Kg + (size_t)(P0 + row) * 1024 + 8 * c), (LAS unsigned*)(lds + buf * AT_STAGE + (wave * 4 + i) * 1024), 16, 0, 0); }
#pragma unroll
    for (int i = 0; i < 4; ++i) { const int row = (wave * 4 + i) * 4 + (lane >> 4), c = (lane & 15) ^ swz_f(row);
        __builtin_amdgcn_global_load_lds((const unsigned*)(Vg + (size_t)(P0 + row) * DIN + 8 * c), (LAS unsigned*)(lds + buf * AT_STAGE + AT_VOFF + (wave * 4 + i) * 1024), 16, 0, 0); }
}
template <bool HALF, int CX, int OFF>
__device__ __forceinline__ void attn5_block(const LAS unsigned char* Kb, const LAS unsigned char* Vb, unsigned ko0, unsigned ko1, unsigned voA, unsigned voB, const bf16x8 (&qf)[4], f32x4 (&o)[8], float& lsum, const LAS float* tj) {
    f32x4 s0 = (f32x4){tj[0], tj[-1], tj[-2], tj[-3]}, s1 = HALF ? (f32x4){0.f, 0.f, 0.f, 0.f} : (f32x4){tj[-4], tj[-5], tj[-6], tj[-7]};
    {   bf16x8 kf0[4];
#pragma unroll
        for (int ks = 0; ks < 4; ++ks) kf0[ks] = *(const LAS bf16x8*)(Kb + (ko0 ^ (unsigned)(64 * ks ^ CX)) + OFF);
        if (!HALF) { bf16x8 kf1[4];
#pragma unroll
            for (int ks = 0; ks < 4; ++ks) kf1[ks] = *(const LAS bf16x8*)(Kb + (ko1 ^ (unsigned)(64 * ks ^ CX)) + OFF);
#pragma unroll
            for (int ks = 0; ks < 4; ++ks) { s0 = __builtin_amdgcn_mfma_f32_16x16x32_bf16(kf0[ks], qf[ks], s0, 0, 0, 0); s1 = __builtin_amdgcn_mfma_f32_16x16x32_bf16(kf1[ks], qf[ks], s1, 0, 0, 0); }
        } else {
#pragma unroll
            for (int ks = 0; ks < 4; ++ks) s0 = __builtin_amdgcn_mfma_f32_16x16x32_bf16(kf0[ks], qf[ks], s0, 0, 0, 0);
        }
    }
    float pv[8];
#pragma unroll
    for (int e = 0; e < (HALF ? 4 : 8); ++e) { const float sv = e < 4 ? s0[e] : s1[e - 4]; pv[e] = __builtin_amdgcn_exp2f(sv); lsum += pv[e]; }
    v4u pw; pw.x = pg8::cvt_pk_bf16(pv[0], pv[1]); pw.y = pg8::cvt_pk_bf16(pv[2], pv[3]);
    if (HALF) { pw.z = 0u; pw.w = 0u; } else { pw.z = pg8::cvt_pk_bf16(pv[4], pv[5]); pw.w = pg8::cvt_pk_bf16(pv[6], pv[7]); }
    const bf16x8 pf = __builtin_bit_cast(bf16x8, pw);
    const unsigned vA = (unsigned)(size_t)Vb + voA, vB = (unsigned)(size_t)Vb + voB;
    s16x4 va[8], vb[8];
#pragma unroll
    for (int dt = 0; dt < 8; ++dt) {
        asm volatile("ds_read_b64_tr_b16 %0, %1 offset:%2" : "=v"(va[dt]) : "v"(vA ^ (unsigned)(32 * dt ^ CX)), "i"(OFF));
        if (!HALF) asm volatile("ds_read_b64_tr_b16 %0, %1 offset:%2" : "=v"(vb[dt]) : "v"(vB ^ (unsigned)(32 * dt ^ CX)), "i"(OFF));
        else vb[dt] = (s16x4){0, 0, 0, 0};
    }
    if (!HALF) asm volatile("s_waitcnt lgkmcnt(0)" : "+v"(va[0]), "+v"(va[1]), "+v"(va[2]), "+v"(va[3]), "+v"(va[4]), "+v"(va[5]), "+v"(va[6]), "+v"(va[7]), "+v"(vb[0]), "+v"(vb[1]), "+v"(vb[2]), "+v"(vb[3]), "+v"(vb[4]), "+v"(vb[5]), "+v"(vb[6]), "+v"(vb[7]) :: "memory");
    else asm volatile("s_waitcnt lgkmcnt(0)" : "+v"(va[0]), "+v"(va[1]), "+v"(va[2]), "+v"(va[3]), "+v"(va[4]), "+v"(va[5]), "+v"(va[6]), "+v"(va[7]) :: "memory");
    __builtin_amdgcn_sched_barrier(0);
#pragma unroll
    for (int dt = 0; dt < 8; ++dt) {
        const bf16x8 vf = (bf16x8){va[dt][0], va[dt][1], va[dt][2], va[dt][3], vb[dt][0], vb[dt][1], vb[dt][2], vb[dt][3]};
        o[dt] = __builtin_amdgcn_mfma_f32_16x16x32_bf16(vf, pf, o[dt], 0, 0, 0);
    }
}
__device__ __forceinline__ const LAS float* tbl_at(const LAS float* tb, int jb) { const int jc = jb < -1 ? -1 : (jb > 137 ? 137 : jb); return tb + jc; }
template <int BUF>
__device__ __forceinline__ void attn2_chunk(LAS unsigned char* lds, const bf16* Kg, const bf16* Vg, int t0, int j, int r0, int wave, int lane, const bf16x8 (&qf)[2][4], f32x4 (&o)[2][8], float (&lsum)[2]) {
    const int Pj = t0 - 2048 + 128 * j;
    if (j + 1 < 18) attn2_stage(lds, BUF ^ 1, Kg, Vg, Pj + 128, wave, lane);
    asm volatile("" ::: "memory");
    const LAS unsigned char* Kb = lds + BUF * AT_STAGE; const LAS unsigned char* Vb = lds + BUF * AT_STAGE + AT_VOFF;
    const LAS float* tbl = (const LAS float*)(lds + AT_TBL);
#pragma unroll
    for (int gi = 0; gi < 2; ++gi) { const int r = r0 + gi;
        int l2 = lane; asm volatile("" : "+v"(l2));
        const int li2 = l2 & 15, qd2 = l2 >> 4, q2 = li2 >> 2, p2 = li2 & 3; const unsigned pt = 8u * (p2 & 1);
        {
            const int row = r + 16 * (li2 & 7), rowA = r + 16 * ((4 * qd2 + q2) & 7);
            const unsigned ko0 = row * 256 + 16 * (qd2 ^ swz_f(row)), voA = rowA * 256 + 16 * ((p2 >> 1) ^ swz_f(rowA)) + pt;
            attn5_block<true, 0, 0>(Kb, Vb, ko0, 0u, voA, 0u, qf[gi], o[gi], lsum[gi], tbl_at(tbl + 2 * 148 + 8, qd2 < 2 ? ((t0 - Pj) >> 4) + li2 - 4 * qd2 : 100000)); }
        if (j >= 12) {
            const int row0 = (r & 3) + 4 * (8 * q2 + p2), row1 = row0 + 16, rowA = (r & 3) + 4 * (8 * qd2 + q2), rowB = rowA + 16;
            const unsigned ko0 = row0 * 256 + 16 * (qd2 ^ swz_f(row0)), ko1 = row1 * 256 + 16 * (qd2 ^ swz_f(row1)), voA = rowA * 256 + 16 * ((p2 >> 1) ^ swz_f(rowA)) + pt, voB = rowB * 256 + 16 * ((p2 >> 1) ^ swz_f(rowB)) + pt;
            attn5_block<false, 0, 0>(Kb, Vb, ko0, ko1, voA, voB, qf[gi], o[gi], lsum[gi], tbl_at(tbl + 148 + 8, ((t0 - Pj) >> 2) + (r >> 2) + 4 * li2 - 8 * qd2)); }
        if (j >= 15) {
            const int row0 = 8 * q2 + p2, row1 = row0 + 4, rowA = 8 * qd2 + q2, rowB = rowA + 4;
            const unsigned ko0 = row0 * 256 + 16 * (qd2 ^ swz_f(row0)), ko1 = row1 * 256 + 16 * (qd2 ^ swz_f(row1)), voA = rowA * 256 + 16 * ((p2 >> 1) ^ swz_f(rowA)) + pt, voB = rowB * 256 + 16 * ((p2 >> 1) ^ swz_f(rowB)) + pt;
            const int jb0 = (t0 - Pj) + r + 16 * li2 - 8 * qd2; const LAS float* tb1 = tbl + 8;
            attn5_block<false, 0, 0>(Kb, Vb, ko0, ko1, voA, voB, qf[gi], o[gi], lsum[gi], tbl_at(tb1, jb0));
            attn5_block<false, 64, 8192>(Kb, Vb, ko0, ko1, voA, voB, qf[gi], o[gi], lsum[gi], tbl_at(tb1, jb0 - 32));
            attn5_block<false, 128, 16384>(Kb, Vb, ko0, ko1, voA, voB, qf[gi], o[gi], lsum[gi], tbl_at(tb1, jb0 - 64));
            attn5_block<false, 192, 24576>(Kb, Vb, ko0, ko1, voA, voB, qf[gi], o[gi], lsum[gi], tbl_at(tb1, jb0 - 96)); }
    }
    asm volatile("s_waitcnt vmcnt(0) lgkmcnt(0)" ::: "memory");
    __builtin_amdgcn_s_barrier(); asm volatile("" ::: "memory");
}
constexpr int FR_SLOT = 4096, FR_WAVE = 4 * FR_SLOT;
__device__ __forceinline__ void far_stage(LAS unsigned char* ring, int slot, const bf16* Kg, const bf16* Vg, int pos0, int lane) {
#pragma unroll
    for (int i = 0; i < 4; ++i) { const int row = 4 * (i & 1) + (lane >> 4), c = (lane & 15) ^ (2 * row);
        const bf16* src = (i < 2 ? Kg + (size_t)(pos0 + 16 * row) * 1024 : Vg + (size_t)(pos0 + 16 * row) * DIN) + 8 * c;
        __builtin_amdgcn_global_load_lds((const unsigned*)src, (LAS unsigned*)(ring + slot * FR_SLOT + i * 1024), 16, 0, 0); }
}
template <int S>
__device__ __forceinline__ void far_step(LAS unsigned char* lds, LAS unsigned char* ring, const bf16* Kg, const bf16* Vg, int t0, int jmin, int r0, int gc, int ngc, int lane, const bf16x8 (&qf)[2][4], f32x4 (&o)[2][8], float (&lsum)[2]) {
    constexpr int gi = S & 1;
    if (gc + 3 < ngc) { const int x = gc + 3; far_stage(ring, (S + 3) & 3, Kg, Vg, t0 - 2048 + 128 * (jmin + (x >> 1)) + r0 + (x & 1), lane); asm volatile("s_waitcnt vmcnt(12)" ::: "memory"); }
    else if (gc + 2 < ngc) asm volatile("s_waitcnt vmcnt(8)" ::: "memory");
    else if (gc + 1 < ngc) asm volatile("s_waitcnt vmcnt(4)" ::: "memory");
    else asm volatile("s_waitcnt vmcnt(0)" ::: "memory");
    const int Pj = t0 - 2048 + 128 * (jmin + (gc >> 1));
    int l2 = lane; asm volatile("" : "+v"(l2));
    const int li2 = l2 & 15, qd2 = l2 >> 4, q2 = li2 >> 2, p2 = li2 & 3, k = li2 & 7, kA = (4 * qd2 + q2) & 7;
    const unsigned ko0 = k * 256 + 16 * (qd2 ^ (2 * k)), voA = kA * 256 + 16 * ((p2 >> 1) ^ (2 * kA)) + 8u * (p2 & 1);
    const LAS unsigned char* Kb = ring + S * FR_SLOT;
    attn5_block<true, 0, 0>(Kb, Kb + 2048, ko0, 0u, voA, 0u, qf[gi], o[gi], lsum[gi], tbl_at((const LAS float*)(lds + AT_TBL) + 2 * 148 + 8, qd2 < 2 ? ((t0 - Pj) >> 4) + li2 - 4 * qd2 : 100000));
    asm volatile("s_waitcnt lgkmcnt(0)" ::: "memory");
}
__device__ __forceinline__ void attn2_prompt_unit(const Args& A, LAS unsigned char* lds, int h, int qt, float Mp) {
    const int tid = opaque_tid(), lane = tid & 63, wave = __builtin_amdgcn_readfirstlane(tid >> 6), li = lane & 15, quad = lane >> 4;
    const bf16* QN = (const bf16*)(A.ws + WS_QN); bf16* MIX = (bf16*)(A.ws + WS_MIX);
    const bf16* Kg = (const bf16*)(A.ws + WS_KN) + h * HD; const bf16* Vg = (const bf16*)(A.ws + WS_PROJ) + 5120 + h * HD;
    LAS float* tbl = (LAS float*)(lds + AT_TBL);
    __syncthreads();
    for (int x = tid; x < 3 * 148; x += NTHR) { const int g = x / 148, jj = x % 148 - 8; float v = -1e30f; if (jj >= 0 && jj <= 128) v = A.rel_bias[BUCKET[g][jj] * NH + h] * LOG2E - Mp; tbl[x] = v; }
    const int t0 = qt * 256, r0 = 2 * wave;
    bf16x8 qf[2][4]; f32x4 o[2][8]; float lsum[2] = {0.f, 0.f};
#pragma unroll
    for (int gi = 0; gi < 2; ++gi) {
#pragma unroll
        for (int ks = 0; ks < 4; ++ks) qf[gi][ks] = ld16(QN + (size_t)(t0 + 16 * li + r0 + gi) * 1024 + h * HD + 32 * ks + 8 * quad);
#pragma unroll
        for (int dt = 0; dt < 8; ++dt) o[gi][dt] = (f32x4){0.f, 0.f, 0.f, 0.f};
    }
    asm volatile("s_waitcnt vmcnt(0) lgkmcnt(0)" ::: "memory");
    __syncthreads();
    const int jmin = (16 - 2 * qt) > 0 ? (16 - 2 * qt) : 0;
    const int jn = jmin > 12 ? jmin : 12;
    if (jmin < 12) {
        LAS unsigned char* ring = lds + wave * FR_WAVE; const int ngc = 2 * (12 - jmin);
        far_stage(ring, 0, Kg, Vg, t0 - 2048 + 128 * jmin + r0, lane); far_stage(ring, 1, Kg, Vg, t0 - 2048 + 128 * jmin + r0 + 1, lane); far_stage(ring, 2, Kg, Vg, t0 - 2048 + 128 * (jmin + 1) + r0, lane);
#pragma unroll 1
        for (int gc = 0; gc < ngc; gc += 4) {
            far_step<0>(lds, ring, Kg, Vg, t0, jmin, r0, gc, ngc, lane, qf, o, lsum); far_step<1>(lds, ring, Kg, Vg, t0, jmin, r0, gc + 1, ngc, lane, qf, o, lsum);
            far_step<2>(lds, ring, Kg, Vg, t0, jmin, r0, gc + 2, ngc, lane, qf, o, lsum); far_step<3>(lds, ring, Kg, Vg, t0, jmin, r0, gc + 3, ngc, lane, qf, o, lsum);
        }
        asm volatile("s_waitcnt vmcnt(0) lgkmcnt(0)" ::: "memory");
        __builtin_amdgcn_s_barrier(); asm volatile("" ::: "memory");
    }
    attn2_stage(lds, 0, Kg, Vg, t0 - 2048 + 128 * jn, wave, lane);
    asm volatile("s_waitcnt vmcnt(0)" ::: "memory");
    __builtin_amdgcn_s_barrier(); asm volatile("" ::: "memory");
#pragma unroll 1
    for (int j = jn; j < 18; j += 2) {
        attn2_chunk<0>(lds, Kg, Vg, t0, j, r0, wave, lane, qf, o, lsum);
        attn2_chunk<1>(lds, Kg, Vg, t0, j + 1, r0, wave, lane, qf, o, lsum);
    }
#pragma unroll
    for (int gi = 0; gi < 2; ++gi) {
        float l = lsum[gi]; l += __shfl_xor(l, 16); l += __shfl_xor(l, 32);
        const float inv = 1.0f / l;
        bf16* orow = MIX + (size_t)(t0 + 16 * li + r0 + gi) * DM + DATT + h * HD + 4 * quad;
#pragma unroll
        for (int dt = 0; dt < 8; ++dt) { v2u w; w.x = pg8::cvt_pk_bf16(o[gi][dt][0] * inv, o[gi][dt][1] * inv); w.y = pg8::cvt_pk_bf16(o[gi][dt][2] * inv, o[gi][dt][3] * inv); *(GAS v2u*)(orow + 16 * dt) = w; }
    }
}
__device__ __forceinline__ void load_q_frags(bf16x8 (&qf)[4], const bf16* qrow, const float* gq, int quad, float scale = QSCALE) {
    float f[32];
#pragma unroll
    for (int ks = 0; ks < 4; ++ks) unpack8(*(const GAS v4u*)(qrow + 32 * ks + 8 * quad), f + 8 * ks);
    float ss = 0.f;
#pragma unroll
    for (int i = 0; i < 32; ++i) ss += f[i] * f[i];
    ss += __shfl_xor(ss, 16); ss += __shfl_xor(ss, 32);
    const float sc = scale / sqrtf(ss * (1.f / HD) + EPS);
#pragma unroll
    for (int ks = 0; ks < 4; ++ks) { const f32x4 g0 = *(const GAS f32x4*)(gq + 32 * ks + 8 * quad), g1 = *(const GAS f32x4*)(gq + 32 * ks + 8 * quad + 4); const float* e = f + 8 * ks;
        v4u w; w.x = pg8::cvt_pk_bf16(e[0] * sc * g0[0], e[1] * sc * g0[1]); w.y = pg8::cvt_pk_bf16(e[2] * sc * g0[2], e[3] * sc * g0[3]); w.z = pg8::cvt_pk_bf16(e[4] * sc * g1[0], e[5] * sc * g1[1]); w.w = pg8::cvt_pk_bf16(e[6] * sc * g1[2], e[7] * sc * g1[3]);
        qf[ks] = __builtin_bit_cast(bf16x8, w); }
}
constexpr int PL_KV = (WBUF + NSAMP) / 32, PL_CONV = MT / 16, PL_ITEMS = PL_KV + PL_CONV;
__device__ __forceinline__ void postlite_item(const Args& A, int item) {
    const int tid = opaque_tid(), lane = tid & 63, wave = __builtin_amdgcn_readfirstlane(tid >> 6);
    const bf16* PROJ = (const bf16*)(A.ws + WS_PROJ); bf16* MIX = (bf16*)(A.ws + WS_MIX);
    if (item < PL_KV) {
        v4u kw[4][2], vw[4][2];
#pragma unroll
        for (int q = 0; q < 4; ++q) { const int tk_ = (SEQ - WBUF) + item * 32 + wave * 4 + q; const bf16* prow = PROJ + (size_t)tk_ * DIN; const GAS v4u* pk = tk_ >= SEQ ? (const GAS v4u*)(prow + 4096 + lane * 16) : (const GAS v4u*)((const bf16*)(A.ws + WS_KN) + (size_t)tk_ * 1024 + lane * 16); const GAS v4u* pv = (const GAS v4u*)(prow + 5120 + lane * 16);
            kw[q][0] = pk[0]; kw[q][1] = pk[1]; vw[q][0] = pv[0]; vw[q][1] = pv[1]; }
        f32x4 g[4];
#pragma unroll
        for (int j = 0; j < 4; ++j) g[j] = *(const GAS f32x4*)(A.k_norm + (lane & 7) * 16 + 4 * j);
#pragma unroll
        for (int q = 0; q < 4; ++q) { const int tok = (SEQ - WBUF) + item * 32 + wave * 4 + q;
            float* ko; float* vo;
            if (tok >= SEQ) { ko = A.out + O_SK + (size_t)(tok - SEQ) * 1024; vo = A.out + O_SV + (size_t)(tok - SEQ) * 1024; }
            else { ko = A.out + O_PK + (size_t)(tok - (SEQ - WBUF)) * 1024; vo = A.out + O_PV + (size_t)(tok - (SEQ - WBUF)) * 1024; }
            float f[16]; unpack8(kw[q][0], f); unpack8(kw[q][1], f + 8);
            float ss = 0.f;
#pragma unroll
            for (int j = 0; j < 16; ++j) ss += f[j] * f[j];
            ss += __shfl_xor(ss, 1); ss += __shfl_xor(ss, 2); ss += __shfl_xor(ss, 4);
            const float rstd = 1.0f / sqrtf(ss * (1.f / HD) + EPS);
            GAS f32x4* o = (GAS f32x4*)(ko + lane * 16);
            if (tok >= SEQ) {
#pragma unroll
                for (int j = 0; j < 4; ++j) __builtin_nontemporal_store((f32x4){f[4 * j] * rstd * g[j][0], f[4 * j + 1] * rstd * g[j][1], f[4 * j + 2] * rstd * g[j][2], f[4 * j + 3] * rstd * g[j][3]}, o + j);
            } else {
#pragma unroll
                for (int j = 0; j < 4; ++j) __builtin_nontemporal_store((f32x4){f[4 * j], f[4 * j + 1], f[4 * j + 2], f[4 * j + 3]}, o + j); }
            unpack8(vw[q][0], f); unpack8(vw[q][1], f + 8);
            GAS f32x4* ov = (GAS f32x4*)(vo + lane * 16);
#pragma unroll
            for (int j = 0; j < 4; ++j) __builtin_nontemporal_store((f32x4){f[4 * j], f[4 * j + 1], f[4 * j + 2], f[4 * j + 3]}, ov + j); }
    } else {
        const int tb = (item - PL_KV) * 16;
#pragma unroll 2
        for (int it = tid; it < 16 * (DCONV / 8); it += NTHR) {
            const int tok = tb + (it >> 7), c8 = (it & 127) * 8;
            const bool samp = tok >= SEQ; const int b = (tok - SEQ) >> 3, i = samp ? ((tok - SEQ) & 7) : tok;
            v4u xw[3], cw[3]; f32x4 s0[2], s1[2];
#pragma unroll
            for (int k = 0; k < 3; ++k) { const int ii = i - 2 + k; const bf16* pr = PROJ + (size_t)(tok - 2 + k) * DIN;
                if (ii >= 0) { xw[k] = *(const GAS v4u*)(pr + c8); cw[k] = *(const GAS v4u*)(pr + 2048 + c8); } else { xw[k] = (v4u){0u, 0u, 0u, 0u}; cw[k] = (v4u){0u, 0u, 0u, 0u}; } }
            if (samp && i < 2) { const float* st = A.state_conv + ((size_t)b * 2) * DCONV + c8; s0[0] = *(const GAS f32x4*)(st); s0[1] = *(const GAS f32x4*)(st + 4); s1[0] = *(const GAS f32x4*)(st + DCONV); s1[1] = *(const GAS f32x4*)(st + DCONV + 4); }
            const v4u bw = *(const GAS v4u*)(PROJ + (size_t)tok * DIN + 1024 + c8);
            float u[3][8];
#pragma unroll
            for (int k = 0; k < 3; ++k) { float xc[8], cg[8]; unpack8(xw[k], xc); unpack8(cw[k], cg);
#pragma unroll
                for (int j = 0; j < 8; ++j) u[k][j] = cg[j] * xc[j]; }
            if (samp && i < 2) {
#pragma unroll
                for (int j = 0; j < 8; ++j) { const float st0 = j < 4 ? s0[0][j] : s0[1][j - 4], st1 = j < 4 ? s1[0][j] : s1[1][j - 4];
                    if (i == 0) { u[0][j] = st0; u[1][j] = st1; } else { u[0][j] = st1; } } }
            float bg[8]; unpack8(bw, bg);
            float y[8];
#pragma unroll
            for (int j = 0; j < 8; ++j) y[j] = bg[j] * (u[0][j] * A.conv_w[c8 + j] + u[1][j] * A.conv_w[DCONV + c8 + j] + u[2][j] * A.conv_w[2 * DCONV + c8 + j]);
            v4u w; w.x = pk2(y[0], y[1]); w.y = pk2(y[2], y[3]); w.z = pk2(y[4], y[5]); w.w = pk2(y[6], y[7]);
            *(GAS v4u*)(MIX + (size_t)tok * DM + c8) = w;
            float* co = nullptr;
            if (samp) { if (i >= 6) co = A.out + O_SC + ((size_t)b * 2 + (i - 6)) * DCONV + c8; }
            else if (tok >= SEQ - 2) co = A.out + O_PC + (size_t)(tok - (SEQ - 2)) * DCONV + c8;
            if (co) {
#pragma unroll
                for (int j = 0; j < 8; ++j) co[j] = u[2][j]; }
        }
    }
}
__device__ __forceinline__ int att_mult(int dist) { return (dist <= 128 ? 1 : 0) + (((dist & 3) == 0 && dist <= 512) ? 1 : 0) + (((dist & 15) == 0 && dist <= 2048) ? 1 : 0); }
constexpr int SROWS = 1288, S_TBL = 0, S_Q = 8256, S_P = S_Q + 4096, S_OP = S_P + SROWS * 32, S_LP = S_OP + 65536, S_KT = 122880, S_END = S_KT + 32768;
__device__ __forceinline__ void attn_sample_unit(const Args& A, LAS unsigned char* lds, int b, int h, float Mp) {
    const int tid = opaque_tid(), lane = tid & 63, wave = __builtin_amdgcn_readfirstlane(tid >> 6);
    const bf16* PROJ = (const bf16*)(A.ws + WS_PROJ); const bf16* QN = (const bf16*)(A.ws + WS_QN); const bf16* KN = (const bf16*)(A.ws + WS_KN); bf16* MIX = (bf16*)(A.ws + WS_MIX);
    LAS float* tblS = (LAS float*)(lds + S_TBL); LAS float* q_s = (LAS float*)(lds + S_Q); LAS float* P_T = (LAS float*)(lds + S_P); LAS float* Opart = (LAS float*)(lds + S_OP); LAS float* lpart = (LAS float*)(lds + S_LP);
    __syncthreads();
    {
        LAS float* rb = q_s; LAS unsigned* bkw = (LAS unsigned*)(q_s + 32);
        if (tid < 32) rb[tid] = A.rel_bias[tid * NH + h] * LOG2E - Mp;
        else if (tid < 32 + 99) bkw[tid - 32] = ((const unsigned*)&BUCKET[0][0])[tid - 32];
        __syncthreads();
        const LAS unsigned char* bkb = (const LAS unsigned char*)bkw;
        for (int x = tid; x < 2064; x += NTHR) { float v = -1e30f;
            if (x <= 2055) { const int c = att_mult(x); if (c > 0) { const int bk = x <= 128 ? bkb[x] : (((x & 3) == 0 && x <= 512) ? bkb[132 + (x >> 2)] : bkb[264 + (x >> 4)]);
                v = (c == 1 ? 0.f : (c == 2 ? 1.f : 1.5849625007211562f)) + rb[bk]; } }
            tblS[x] = v; }
    }
    __syncthreads();
    {
        const int li = lane & 15, quad = lane >> 4;
        bf16x8 qf[4];
#pragma unroll
        for (int ks = 0; ks < 4; ++ks) qf[ks] = (bf16x8){0, 0, 0, 0, 0, 0, 0, 0};
        load_q_frags(qf, PROJ + (size_t)(SEQ + b * 8 + (li & 7)) * DIN + 3072 + h * HD, A.q_norm, quad);
        const float* kbase = A.cache_k + ((size_t)b * WBUF * NH + h) * HD + 4 * (lane & 31);
        f32x4 ka[8], kb[8];
        const int half_ = lane >> 5, l32_ = lane & 31;
        LAS unsigned char* ktile = lds + S_KT + wave * 4096;
#define SC_LOAD(dst, ti) do { _Pragma("unroll") for (int x_ = 0; x_ < 8; ++x_) { const int n_ = 16 * (ti) + 2 * x_ + half_, p_ = n_ < 768 ? ((n_ >> 3) * 16 + (n_ & 7)) : n_ + 768; \
            dst[x_] = __builtin_nontemporal_load((const GAS f32x4*)(kbase + (size_t)p_ * (NH * HD))); } } while (0)
#define SC_TILE(src_, ti) do { f32x4 s_ = (f32x4){0.f, 0.f, 0.f, 0.f}; \
        _Pragma("unroll") for (int x_ = 0; x_ < 8; ++x_) { const int row_ = 2 * x_ + half_; v2u w_; w_.x = pg8::cvt_pk_bf16(src_[x_][0], src_[x_][1]); w_.y = pg8::cvt_pk_bf16(src_[x_][2], src_[x_][3]); \
            *(LAS v2u*)(ktile + row_ * 256 + 16 * ((l32_ >> 1) ^ row_) + 8 * (l32_ & 1)) = w_; }              \
        asm volatile("s_waitcnt lgkmcnt(0)" ::: "memory"); \
        _Pragma("unroll") for (int ks = 0; ks < 4; ++ks) { const bf16x8 kf_ = *(const LAS bf16x8*)(ktile + li * 256 + 16 * ((4 * ks + quad) ^ li)); \
            s_ = __builtin_amdgcn_mfma_f32_16x16x32_bf16(kf_, qf[ks], s_, 0, 0, 0); } \
        if (li < 8) { _Pragma("unroll") for (int rg = 0; rg < 4; ++rg) { const int n_ = 16 * (ti) + 4 * quad + rg, p_ = n_ < 768 ? ((n_ >> 3) * 16 + (n_ & 7)) : n_ + 768, dist_ = WBUF + li - p_; \
            P_T[n_ * 8 + li] = __builtin_amdgcn_exp2f(s_[rg] + tblS[dist_ < 0 ? 2056 : dist_]); } } } while (0)
        SC_LOAD(ka, wave);
#pragma unroll 1
        for (int k = 0; k < 8; k += 2) {
            SC_LOAD(kb, wave + NWAVES * (k + 1));
            SC_TILE(ka, wave + NWAVES * k);
            SC_LOAD(ka, wave + NWAVES * (k + 2));
            SC_TILE(kb, wave + NWAVES * (k + 1));
        }
        SC_LOAD(kb, wave + NWAVES * 9);
        SC_TILE(ka, wave + NWAVES * 8);
        SC_TILE(kb, wave + NWAVES * 9);
#undef SC_LOAD
#undef SC_TILE
        if (wave == 0) {
            f32x4 s_ = (f32x4){0.f, 0.f, 0.f, 0.f};
            bf16x8 kn[4]; load_q_frags(kn, PROJ + (size_t)(SEQ + b * 8 + (li & 7)) * DIN + 4096 + h * HD, A.k_norm, quad, 1.0f);
#pragma unroll
            for (int ks = 0; ks < 4; ++ks) s_ = __builtin_amdgcn_mfma_f32_16x16x32_bf16(kn[ks], qf[ks], s_, 0, 0, 0);
            if (li < 8 && quad < 2) {
#pragma unroll
                for (int rg = 0; rg < 4; ++rg) { const int rr = 4 * quad + rg, dist_ = li - rr; P_T[(SROWS - 8 + rr) * 8 + li] = __builtin_amdgcn_exp2f(s_[rg] + tblS[dist_ < 0 ? 2056 : dist_]); } }
        }
    }
    __syncthreads();
    {
        const int half = lane >> 5, l32 = lane & 31;
        f32x4 o[8]; float la[8];
#pragma unroll
        for (int i = 0; i < 8; ++i) { o[i] = (f32x4){0.f, 0.f, 0.f, 0.f}; la[i] = 0.f; }
        const float* vbase = A.cache_v + ((size_t)b * WBUF * NH + h) * HD + 4 * l32;
        f32x4 va[8], vb[8];
#define PV_LOAD(dst, k0) do { _Pragma("unroll") for (int u = 0; u < 8; ++u) { const int n_ = 2 * (wave + NWAVES * ((k0) + u)) + half, p_ = n_ < 768 ? ((n_ >> 3) * 16 + (n_ & 7)) : n_ + 768; dst[u] = __builtin_nontemporal_load((const GAS f32x4*)(vbase + (size_t)p_ * (NH * HD))); } } while (0)
#define PV_ACC(src_, k0) do { _Pragma("unroll") for (int u = 0; u < 8; ++u) { const int n_ = 2 * (wave + NWAVES * ((k0) + u)) + half; \
            const f32x4 pa = *(const LAS f32x4*)(P_T + n_ * 8), pb = *(const LAS f32x4*)(P_T + n_ * 8 + 4); \
            _Pragma("unroll") for (int i = 0; i < 4; ++i) { o[i] += src_[u] * pa[i]; la[i] += pa[i]; o[4 + i] += src_[u] * pb[i]; la[4 + i] += pb[i]; } } } while (0)
        PV_LOAD(va, 0);
#pragma unroll 1
        for (int k0 = 0; k0 < 64; k0 += 16) {
            PV_LOAD(vb, k0 + 8);
            PV_ACC(va, k0);
            PV_LOAD(va, k0 + 16);
            PV_ACC(vb, k0 + 8);
        }
        PV_LOAD(vb, 72);
        PV_ACC(va, 64);
        PV_ACC(vb, 72);
#undef PV_LOAD
#undef PV_ACC
        if (wave < 4) {
            const int n = SROWS - 8 + 2 * wave + half; const v2u w = *(const GAS v2u*)(PROJ + (size_t)(SEQ + b * 8 + (n - (SROWS - 8))) * DIN + 5120 + h * HD + 4 * l32);
            const f32x4 vv = (f32x4){bf_lo(w.x), bf_hi(w.x), bf_lo(w.y), bf_hi(w.y)};
            const f32x4 pa = *(const LAS f32x4*)(P_T + n * 8), pb = *(const LAS f32x4*)(P_T + n * 8 + 4);
#pragma unroll
            for (int i = 0; i < 4; ++i) { o[i] += vv * pa[i]; la[i] += pa[i]; o[4 + i] += vv * pb[i]; la[4 + i] += pb[i]; }
        }
        const int hw = wave * 2 + half;
#pragma unroll
        for (int i = 0; i < 8; ++i) { *(LAS f32x4*)(Opart + (hw * 8 + i) * 128 + 4 * l32) = o[i]; if (l32 == 0) lpart[hw * 8 + i] = la[i]; }
    }
    __syncthreads();
    {   const int i = tid >> 6, d = 2 * (tid & 63); float a0 = 0.f, a1 = 0.f, l = 0.f;
#pragma unroll
        for (int w = 0; w < 2 * NWAVES; ++w) { const f32x2 v = *(const LAS f32x2*)(Opart + (w * 8 + i) * 128 + d); a0 += v.x; a1 += v.y; l += lpart[w * 8 + i]; }
        const float inv = 1.0f / l;
        *(GAS unsigned*)(MIX + (size_t)(SEQ + b * 8 + i) * DM + DATT + h * HD + d) = pk2(a0 * inv, a1 * inv);
    }
}
__device__ __forceinline__ void phase_attn(const Args& A, LAS unsigned char* lds, int vcu, int G) {
    const float Mp = softmax_bound_l2(A, threadIdx.x & 63);
    for (int pass = 0; pass < 2; ++pass) {
        const bool prompt = ((vcu & 1) == 0) == (pass == 0);
#ifndef REP_PR
#define REP_PR 1
#endif
#ifndef REP_SA
#define REP_SA 1
#endif
        if (prompt) { for (int rep = 0; rep < REP_PR; ++rep) for (int u = vcu; u < NH * (SEQ / 256); u += G) attn2_prompt_unit(A, lds, u >> 5, u & 31, Mp); }
        else { for (int rep = 0; rep < REP_SA; ++rep) for (int u = vcu; u < DBATCH * NH; u += G) attn_sample_unit(A, lds, u >> 3, u & 7, Mp); }
    }
    volatile LAS int* qslot = (volatile LAS int*)(lds + LDS_ST_OFF + 16);
    for (;;) {
        __syncthreads();
        if (threadIdx.x == 0) *qslot = (int)__hip_atomic_fetch_add((unsigned*)(A.ws + WS_CTL), 1u, __ATOMIC_RELAXED, __HIP_MEMORY_SCOPE_AGENT);
        __syncthreads();
        const int item = *qslot;
        if (item >= PL_ITEMS + PL_GU) break;
        if (item < PL_ITEMS) postlite_item(A, item); else convert_gu_item(A, lds, item - PL_ITEMS);
    }
}

template <int N> __device__ __forceinline__ void wait_vm() { asm volatile("s_waitcnt vmcnt(%0)" :: "n"(N) : "memory"); }
template <int MB, int NB, int KC, int NSLOT, int NCH, class Epi>
__device__ __forceinline__ void skinny2(const bf16* A, const bf16* Bt, int tile, LAS unsigned char* lds, const Epi& E) {
    constexpr int K = KC * NCH, RT = 256 / (16 * MB), W = 16 * NB, R = 16 * (MB + NB), ROWB = KC * 2, CHB = R * ROWB, LPR = ROWB / 16, RPI = 64 / LPR, NI = R / RPI, NL = NI / 8, NJ = MB * NB / 8, KS = KC / 32;
    static_assert(NI % 8 == 0 && NSLOT * CHB <= 131072 && (MB * NB) % 8 == 0 && 8 % MB == 0 && LPR >= 16 && NSLOT >= 3, "skinny2 shape");
    const int tid = opaque_tid(), lane = tid & 63, wave = __builtin_amdgcn_readfirstlane(tid >> 6), fr = lane & 15, fq = lane >> 4;
    const int rt = tile % RT, ct = tile / RT;
    const bf16* gp[NL];
#pragma unroll
    for (int i = 0; i < NL; ++i) { const int q = wave + 8 * i, row = q * RPI + lane / LPR, piece = (lane % LPR) ^ (row & 15);
        const bf16* rp = row < 16 * MB ? A + (size_t)(16 * MB * rt + row) * K : Bt + (size_t)(W * ct + row - 16 * MB) * K; gp[i] = rp + 8 * piece; }
    const int mi = wave % MB, g = wave / MB;
    f32x4 acc[NJ];
#pragma unroll
    for (int j = 0; j < NJ; ++j) acc[j] = (f32x4){0.f, 0.f, 0.f, 0.f};
    const unsigned aoff = (unsigned)(16 * mi + fr) * ROWB, boff = (unsigned)(16 * MB + 16 * NJ * g + fr) * ROWB;
#define SK2_STAGE(c) do { _Pragma("unroll") for (int i_ = 0; i_ < NL; ++i_) __builtin_amdgcn_global_load_lds((const unsigned*)(gp[i_] + (size_t)(c) * KC), (LAS unsigned*)(lds + ((c) % NSLOT) * CHB + (wave + 8 * i_) * 1024), 16, 0, 0); } while (0)
#pragma unroll
    for (int c = 0; c < NSLOT - 1; ++c) if (c < NCH) SK2_STAGE(c);
#pragma unroll
    for (int c = 0; c < NCH; ++c) {
        const int ahead = (NCH - 1 - c) < (NSLOT - 2) ? (NCH - 1 - c) : (NSLOT - 2);
        if (ahead >= 2) wait_vm<2 * NL>(); else if (ahead == 1) wait_vm<NL>(); else wait_vm<0>();
        __builtin_amdgcn_s_barrier(); asm volatile("" ::: "memory");
        if (c + NSLOT - 1 < NCH) SK2_STAGE(c + NSLOT - 1);
        const LAS unsigned char* sb = lds + (c % NSLOT) * CHB;
#pragma unroll
        for (int kk = 0; kk < KS; ++kk) { const unsigned po = 16u * (unsigned)((4 * kk + fq) ^ fr);
            const bf16x8 af = *(const LAS bf16x8*)(sb + aoff + po);
#pragma unroll
            for (int j = 0; j < NJ; ++j) { const bf16x8 bf = *(const LAS bf16x8*)(sb + boff + j * 16 * ROWB + po); acc[j] = __builtin_amdgcn_mfma_f32_16x16x32_bf16(bf, af, acc[j], 0, 0, 0); } }
    }
#undef SK2_STAGE
    asm volatile("s_waitcnt lgkmcnt(0)" ::: "memory");
    __syncthreads();
#pragma unroll
    for (int j = 0; j < NJ; ++j) *(LAS f32x4*)(lds + ((16 * mi + fr) * W + 16 * (NJ * g + j) + 4 * fq) * 4) = acc[j];
    __syncthreads();
    constexpr int NCHK = 16 * MB * W / 4;
#pragma unroll
    for (int i = 0; i < NCHK / NTHR; ++i) { const int ch = tid + NTHR * i, row = ch / (W / 4), c4 = ch % (W / 4);
        const f32x4 v = *(const LAS f32x4*)(lds + (row * W + 4 * c4) * 4);
        E(16 * MB * rt + row, W * ct + 4 * c4, ct, v); }
    __syncthreads();
}
struct SkProj { bf16* PROJ; __device__ __forceinline__ void operator()(int row, int col, int, f32x4 v) const { v2u w; w.x = pg8::cvt_pk_bf16(v[0], v[1]); w.y = pg8::cvt_pk_bf16(v[2], v[3]); *(GAS v2u*)(PROJ + (size_t)(SEQ + row) * DIN + col) = w; } };
struct SkRes1 { const float* xs; bf16* X1b; float* SSQ;
    __device__ __forceinline__ void operator()(int row, int col, int ct, f32x4 v) const {
        const f32x4 o = *(const GAS f32x4*)(xs + (size_t)row * DM + col) + v; const size_t off = (size_t)(SEQ + row) * DM + col;
        v2u pk; pk.x = pg8::cvt_pk_bf16(o[0], o[1]); pk.y = pg8::cvt_pk_bf16(o[2], o[3]); *(GAS v2u*)(X1b + off) = pk;
        float ss = (o[0] * o[0] + o[1] * o[1]) + (o[2] * o[2] + o[3] * o[3]); ss += __shfl_xor(ss, 1); ss += __shfl_xor(ss, 2); ss += __shfl_xor(ss, 4); ss += __shfl_xor(ss, 8);
        if ((threadIdx.x & 15) == 0) SSQ[(size_t)(SEQ + row) * 32 + ct] = ss; } };
struct SkOut { const bf16* X1b; float* out; __device__ __forceinline__ void operator()(int row, int col, int, f32x4 v) const { const size_t off = (size_t)(SEQ + row) * DM + col; const v2u w = *(const GAS v2u*)(X1b + off);
        *(GAS f32x4*)(out + off) = (f32x4){bf_lo(w.x), bf_hi(w.x), bf_lo(w.y), bf_hi(w.y)} + v; } };

#define XB_TMO      128
#define XB_XCNT(j)  (256  + 64 * (j))
#define XB_XSUB(j)  (1280 + 64 * (j))
#define XB_XGEN(j)  (2304 + 64 * (j))
#define XB_TOP      3328
#define XB_TOPGEN   3392
#define XCD_BAR_WORDS 3456
#define XB_SPIN_CAP (1u << 18)
__device__ __forceinline__ unsigned xb_ld(unsigned* p)              { return __hip_atomic_load(p, __ATOMIC_RELAXED, __HIP_MEMORY_SCOPE_AGENT); }
__device__ __forceinline__ unsigned xb_add(unsigned* p, unsigned v) { return __hip_atomic_fetch_add(p, v, __ATOMIC_RELAXED, __HIP_MEMORY_SCOPE_AGENT); }
__device__ __forceinline__ unsigned xb_xcc_id() { return (unsigned)__builtin_amdgcn_s_getreg((3 << 11) | 20) & 0xFu; }
#define XB_SPIN(cond, bar) do { unsigned _sp = 0; while (cond) { __builtin_amdgcn_s_sleep(1); \
    if ((++_sp & 255u) == 0u) { if (xb_ld(&(bar)[XB_TMO])) break; if (_sp > XB_SPIN_CAP) { atomicAdd(&(bar)[XB_TMO], 1u); break; } } } } while (0)
struct XcdBarrier { unsigned* bar; unsigned x; volatile LAS unsigned* st; };
__device__ __forceinline__ XcdBarrier xcd_barrier_post(unsigned* bar, volatile LAS unsigned* st) {
    XcdBarrier b; b.bar = bar; b.x = xb_xcc_id(); b.st = st;
    if (threadIdx.x == 0) (void)xb_add(&bar[XB_XCNT(b.x)], 1u);
    return b;
}
__device__ __forceinline__ void xcd_barrier_complete(unsigned* bar, unsigned x, unsigned& nloc, unsigned& nx) {
    const unsigned G = gridDim.x * gridDim.y * gridDim.z;
    unsigned sum, cnt, mine, sp = 0u;
    for (;;) {
        sum = 0u; cnt = 0u; mine = 0u;
#pragma unroll
        for (unsigned j = 0; j < 16; ++j) { const unsigned c = xb_ld(&bar[XB_XCNT(j)]); sum += c; cnt += (c > 0u) ? 1u : 0u; mine = (j == x) ? c : mine; }
        if (sum == G) break;
        __builtin_amdgcn_s_sleep(1);
        if ((++sp & 255u) == 0u) { if (xb_ld(&bar[XB_TMO])) break; if (sp > XB_SPIN_CAP) { atomicAdd(&bar[XB_TMO], 1u); break; } }
    }
    nloc = mine > 0u ? mine : 1u; nx = cnt > 0u ? cnt : 1u;
}
__device__ __forceinline__ void xcd_barrier(const XcdBarrier& b) {
    asm volatile("s_waitcnt vmcnt(0)" ::: "memory");
    __syncthreads();
    if (threadIdx.x == 0) {
        unsigned* bar = b.bar;
        __builtin_amdgcn_s_waitcnt(0);
        unsigned nloc = b.st[0], nx = b.st[1];
        if (nloc == 0u) { xcd_barrier_complete(bar, b.x, nloc, nx); b.st[0] = nloc; b.st[1] = nx; }
        const unsigned old = xb_add(&bar[XB_XSUB(b.x)], 1u);
        const unsigned gen = old / nloc;
        if (old + 1u == (gen + 1u) * nloc) {
            __builtin_amdgcn_fence(__ATOMIC_RELEASE, "agent");
            asm volatile("s_waitcnt vmcnt(0)" ::: "memory");
            const unsigned og = xb_add(&bar[XB_TOP], 1u);
            const unsigned tg = og / nx;
            if (og + 1u == (tg + 1u) * nx) xb_add(&bar[XB_TOPGEN], 1u);
            else XB_SPIN(xb_ld(&bar[XB_TOPGEN]) == tg, bar);
            __builtin_amdgcn_fence(__ATOMIC_ACQUIRE, "agent");
            xb_add(&bar[XB_XGEN(b.x)], 1u);
            asm volatile("s_waitcnt vmcnt(0)" ::: "memory");
        } else {
            XB_SPIN(xb_ld(&bar[XB_XGEN(b.x)]) == gen, bar);
            __builtin_amdgcn_fence(__ATOMIC_ACQUIRE, "agent");
            asm volatile("s_waitcnt vmcnt(0)" ::: "memory");
        }
    }
    __syncthreads();
}
constexpr int CW_BAR = 4096;
constexpr size_t CTL_ZERO_BYTES = 65536;

namespace cg = cooperative_groups;
__device__ __forceinline__ int vcu_of(int bx, int G) { return (G % 8 == 0) ? (bx % 8) * (G / 8) + bx / 8 : bx; }
__global__ void __launch_bounds__(NTHR, 2) fwd_mega(Args A) {
    extern __shared__ __attribute__((aligned(16))) unsigned char lds_raw[];
    LAS unsigned char* lds = (LAS unsigned char*)lds_raw;
    const int G = gridDim.x, bx = blockIdx.x, vcu = vcu_of(bx, G);
    volatile LAS unsigned* st = (volatile LAS unsigned*)(lds + LDS_ST_OFF);
    if (threadIdx.x < 2) st[threadIdx.x] = 0u;
    __syncthreads();
    const XcdBarrier bar = xcd_barrier_post((unsigned*)(A.ws + WS_CTL) + CW_BAR, st);
#if defined(MK_CG_SYNC)
    cg::grid_group grid = cg::this_grid();
#define SEAM() grid.sync()
#else
#define SEAM() xcd_barrier(bar)
#endif
#ifndef REP_G1
#define REP_G1 1
#endif
#ifndef REP_G1S
#define REP_G1S 1
#endif
#ifndef REP_G2
#define REP_G2 1
#endif
#ifndef REP_G2S
#define REP_G2S 1
#endif
#ifndef REP_G3
#define REP_G3 1
#endif
#ifndef REP_G4
#define REP_G4 1
#endif
#ifndef REP_G4S
#define REP_G4S 1
#endif
#ifndef REP_P0
#define REP_P0 1
#endif
#ifndef REP_P2
#define REP_P2 1
#endif
#ifndef REP_P3
#define REP_P3 1
#endif
    for (int rep = 0; rep < REP_P0; ++rep) phase_prologue(A, lds, vcu, G);
    SEAM();
#pragma unroll 1
    for (int pass_ = 0; pass_ < 2; ++pass_) { if ((pass_ == 0) == ((vcu & 1) == 0)) {
for (int rep_ = 0; rep_ < REP_G1; ++rep_) { pg8::Gemm g{(const bf16*)(A.ws + WS_XN), (const bf16*)(A.ws + WS_WIN), SEQ, DIN, DM}; pg8::StaticOrder S; S.init(SEQ, DIN, G, bx);
      pg8::EpiProj E{(bf16*)(A.ws + WS_PROJ), DIN, (bf16*)(A.ws + WS_QN), (bf16*)(A.ws + WS_KN), A.q_norm, A.k_norm, A.out + O_PK, A.out + O_PV, (LAS float*)(lds + 135168)}; pg8::gemm_phase<pg8::EpiProj, pg8::StaticOrder, true, true>(lds, g, S, E); }
    } else {
for (int rep_ = 0; rep_ < REP_G1S; ++rep_) for (int t = vcu; t < 256; t += G) skinny2<4, 6, 128, 3, DM / 128>((const bf16*)(A.ws + WS_XN) + (size_t)SEQ * DM, (const bf16*)(A.ws + WS_WIN), t, lds, SkProj{(bf16*)(A.ws + WS_PROJ)});
    } }
    SEAM();
    for (int rep = 0; rep < REP_P3; ++rep) phase_attn(A, lds, vcu, G);
    SEAM();
#pragma unroll 1
    for (int pass_ = 0; pass_ < 2; ++pass_) { if ((pass_ == 0) == ((vcu & 1) == 0)) {
for (int rep_ = 0; rep_ < REP_G2; ++rep_) { pg8::Gemm g{(const bf16*)(A.ws + WS_MIX), (const bf16*)(A.ws + WS_WOUT), SEQ, DM, DM}; pg8::StaticOrder S; S.init(SEQ, DM, G, bx);
      pg8::EpiRes1 E{A.x_prompt, (bf16*)(A.ws + WS_XN2), (float*)(A.ws + WS_SSQ)}; pg8::gemm_phase<pg8::EpiRes1, pg8::StaticOrder, true, true>(lds, g, S, E); }
    } else {
for (int rep_ = 0; rep_ < REP_G2S; ++rep_) for (int t = vcu; t < 256; t += G) skinny2<2, 4, 128, 4, DM / 128>((const bf16*)(A.ws + WS_MIX) + (size_t)SEQ * DM, (const bf16*)(A.ws + WS_WOUT), t, lds, SkRes1{A.x_sample, (bf16*)(A.ws + WS_XN2), (float*)(A.ws + WS_SSQ)});
    } }
    SEAM();
for (int rep_ = 0; rep_ < REP_G3; ++rep_) { pg8::Gemm g{(const bf16*)(A.ws + WS_XN2), (const bf16*)(A.ws + WS_WGU), MT, NGU, DM}; pg8::StaticOrder S; S.init(MT, NGU, G, bx);
      pg8::EpiSwiGLU E{(const float*)(A.ws + WS_SSQ), (bf16*)(A.ws + WS_H)}; pg8::gemm_phase<pg8::EpiSwiGLU, pg8::StaticOrder, true, true>(lds, g, S, E); }
    { constexpr int NU3 = (MT / 256) * (NGU / 256); const int full = NU3 % G;
      if (full != 0 && bx >= full) convert_wdown(A, lds, bx - full, G - full); else if (full == 0) convert_wdown(A, lds, bx, G); }
    SEAM();
#pragma unroll 1
    for (int pass_ = 0; pass_ < 2; ++pass_) { if ((pass_ == 0) == ((vcu & 1) == 0)) {
for (int rep_ = 0; rep_ < REP_G4; ++rep_) { pg8::Gemm g{(const bf16*)(A.ws + WS_H), (const bf16*)(A.ws + WS_WDN), SEQ, DM, DFF}; pg8::StaticOrder S; S.init(SEQ, DM, G, bx);
      pg8::EpiOut E{(const bf16*)(A.ws + WS_XN2), A.out + O_Y}; pg8::gemm_phase<pg8::EpiOut, pg8::StaticOrder, true, true>(lds, g, S, E); }
    } else {
for (int rep_ = 0; rep_ < REP_G4S; ++rep_) for (int t = vcu; t < 256; t += G) skinny2<2, 4, 128, 4, DFF / 128>((const bf16*)(A.ws + WS_H) + (size_t)SEQ * DFF, (const bf16*)(A.ws + WS_WDN), t, lds, SkOut{(const bf16*)(A.ws + WS_XN2), A.out + O_Y});
    } }
}

extern "C" void kernel_launch(void* const* d_in, const int* in_sizes, int n_in, void* d_out, int out_size, void* d_ws, size_t ws_size, hipStream_t stream) {
    static int grid = 0;
    if (grid == 0) {
        if (n_in != 16 || (size_t)out_size != O_END || ws_size < WS_END) { fprintf(stderr, "kernel_launch: unexpected shapes: n_in %d out %d ws %zu\n", n_in, out_size, ws_size); grid = -1; return; }
        int dev = 0, cus = 0, per_cu = 0;
        if (hipGetDevice(&dev) != hipSuccess || hipDeviceGetAttribute(&cus, hipDeviceAttributeMultiprocessorCount, dev) != hipSuccess) { grid = -1; return; }
        if (hipFuncSetAttribute((const void*)fwd_mega, hipFuncAttributeMaxDynamicSharedMemorySize, LDS_BYTES) != hipSuccess) { fprintf(stderr, "kernel_launch: hipFuncSetAttribute failed\n"); grid = -1; return; }
        if (hipOccupancyMaxActiveBlocksPerMultiprocessor(&per_cu, (const void*)fwd_mega, NTHR, LDS_BYTES) != hipSuccess || per_cu < 1) { fprintf(stderr, "kernel_launch: occupancy query failed (%d)\n", per_cu); (void)hipGetLastError(); per_cu = 1; }
        if (per_cu > 1) per_cu = 1;
        grid = cus * per_cu;
    }
    if (grid < 0) return;
    Args a{};
    a.x_prompt = (const float*)d_in[0]; a.x_sample = (const float*)d_in[1]; a.cache_k = (const float*)d_in[2]; a.cache_v = (const float*)d_in[3]; a.state_conv = (const float*)d_in[4]; a.norm_mix = (const float*)d_in[5];
    a.w_in = (const float*)d_in[6]; a.conv_w = (const float*)d_in[7]; a.q_norm = (const float*)d_in[8]; a.k_norm = (const float*)d_in[9]; a.rel_bias = (const float*)d_in[10]; a.w_out = (const float*)d_in[11];
    a.norm_ffn = (const float*)d_in[12]; a.w_gate = (const float*)d_in[13]; a.w_up = (const float*)d_in[14]; a.w_down = (const float*)d_in[15];
    a.out = (float*)d_out; a.ws = (unsigned char*)d_ws;
    if (hipMemsetAsync((char*)d_ws + WS_CTL, 0, CTL_ZERO_BYTES, stream) != hipSuccess) { fprintf(stderr, "kernel_launch: memset of the control words failed\n"); return; }
    void* args[] = {&a};
    hipError_t e = hipLaunchCooperativeKernel((const void*)fwd_mega, dim3(grid), dim3(NTHR), args, LDS_BYTES, stream);
    if (e != hipSuccess) fprintf(stderr, "kernel_launch: cooperative launch failed: %s (grid %d)\n", hipGetErrorString(e), grid);
}
```

```cpp
#include <hip/hip_runtime.h>
#include <hip/hip_cooperative_groups.h>
#include <cstdio>
#include <cstdint>

constexpr int DM = 2048, SEQ = 8192, DBATCH = 32, DSEQ = 8, NSAMP = DBATCH * DSEQ, MT = SEQ + NSAMP;
constexpr int HD = 128, NH = 8, DATT = 1024, DCONV = 1024, DFF = 5632, DIN = 6144, WBUF = 2048, NGU = 2 * DFF;
constexpr float EPS = 1e-6f;
constexpr float LOG2E = 1.4426950408889634f;
constexpr float QSCALE = 0.08838834764831845f * LOG2E;

__device__ const unsigned char BUCKET[3][132] __attribute__((aligned(16))) = {
{0,1,2,3,4,5,6,7,8,9,10,11,12,13,14,15,16,16,16,16,16,16,17,17,17,17,17,17,17,17,18,18,18,18,18,18,18,18,18,18,19,19,19,19,19,19,19,19,19,19,19,19,19,19,20,20,20,20,20,20,20,20,20,20,20,20,20,20,20,20,20,20,20,21,21,21,21,21,21,21,21,21,21,21,21,21,21,21,21,21,21,21,21,21,21,21,21,21,21,22,22,22,22,22,22,22,22,22,22,22,22,22,22,22,22,22,22,22,22,22,22,22,22,22,22,22,22,22,22,0,0,0},
{0,4,8,12,16,16,17,17,18,18,19,19,19,19,20,20,20,20,20,21,21,21,21,21,21,22,22,22,22,22,22,22,22,22,23,23,23,23,23,23,23,23,23,23,23,23,24,24,24,24,24,24,24,24,24,24,24,24,24,24,24,24,25,25,25,25,25,25,25,25,25,25,25,25,25,25,25,25,25,25,25,25,25,26,26,26,26,26,26,26,26,26,26,26,26,26,26,26,26,26,26,26,26,26,26,26,26,26,26,26,26,26,26,27,27,27,27,27,27,27,27,27,27,27,27,27,27,27,27,0,0,0},
{0,16,18,19,20,21,21,22,22,23,23,23,24,24,24,24,25,25,25,25,25,26,26,26,26,26,26,26,26,27,27,27,27,27,27,27,27,27,27,28,28,28,28,28,28,28,28,28,28,28,28,28,29,29,29,29,29,29,29,29,29,29,29,29,29,29,29,29,29,29,30,30,30,30,30,30,30,30,30,30,30,30,30,30,30,30,30,30,30,30,30,30,30,30,30,31,31,31,31,31,31,31,31,31,31,31,31,31,31,31,31,31,31,31,31,31,31,31,31,31,31,31,31,31,31,31,31,31,31,0,0,0}};

#ifndef REP_E1
#define REP_E1 1
#endif
#ifndef REP_E2
#define REP_E2 1
#endif
#ifndef REP_E3
#define REP_E3 1
#endif
#ifndef REP_E4
#define REP_E4 1
#endif
#ifndef PG8_ROWMAJOR
#define PG8_ROWMAJOR 1
#endif
namespace pg8 {
#define PG8_LAS __attribute__((address_space(3)))
typedef unsigned short bf16_t;
typedef short bf16x8 __attribute__((ext_vector_type(8)));
typedef float f32x4 __attribute__((ext_vector_type(4)));
typedef unsigned u32x4 __attribute__((ext_vector_type(4)));
typedef unsigned u32x2 __attribute__((ext_vector_type(2)));
constexpr int BM = 256, BK = 64, HALF = 128, HTB = HALF * BK * 2  , STAGE_BYTES = 8 * HTB, NXCD = 8, WGM = 8;

__host__ __device__ __forceinline__ int lds_byte(int r, int c) { const int st = (r >> 4) * 2 + (c >> 5), rr = r & 15, cc = c & 31, ob = rr * 64 + cc * 2; return st * 1024 + (ob ^ (((ob >> 9) & 1) << 5)); }
__host__ __device__ __forceinline__ void stage_rc(int b, int& R, int& C) { const int st = b / 1024, sb = b % 1024, swz = sb ^ (((sb >> 9) & 1) << 5); R = (st >> 1) * 16 + swz / 64; C = (st & 1) * 32 + (swz % 64) / 2; }
__host__ __device__ __forceinline__ int perm32(int rho) { const int n = rho >> 4, i = rho & 15; return 8 * (i >> 2) + 4 * n + (i & 3); }

struct Unit { int pm, pn; };
struct Gemm { const bf16_t* A; const bf16_t* Bt; int M, N, K; };

struct StaticOrder {
    int nM, nN, nwg, G, c;
    __host__ __device__ void init(int M, int N, int G_, int c_) { nM = M / BM; nN = N / BM; nwg = nM * nN; G = G_; c = c_; }
    __host__ __device__ bool next(int i, Unit& u) const {
        const long L = (long)i * G + c; if (L >= nwg) return false;
        int wgid = (int)L; { const int q = nwg / NXCD, r = nwg % NXCD, xcd = wgid % NXCD, off = wgid / NXCD; wgid = (xcd < r ? xcd * (q + 1) : r * (q + 1) + (xcd - r) * q) + off; }
        const int nig = WGM * nN, gid = wgid / nig, fm = gid * WGM, gsz = (nM - fm) < WGM ? (nM - fm) : WGM;
        u.pm = fm + ((wgid % nig) % gsz); u.pn = (wgid % nig) / gsz; return true;
    }
    __device__ __forceinline__ void a_ready(const Unit&) const {}
    __device__ __forceinline__ void done(const Unit&) const {}
};

__device__ __forceinline__ unsigned cvt_pk_bf16(float lo, float hi) { unsigned r; asm volatile("v_cvt_pk_bf16_f32 %0, %1, %2" : "=v"(r) : "v"(lo), "v"(hi)); return r; }

struct EpiProj {
    static constexpr int REPS = REP_E1; static constexpr bool PERM = true, AFTER_DRAIN = false;
    bf16_t* O; int ldc; bf16_t* QN; bf16_t* KN; const float* gq; const float* gk; float* out_k; float* out_v; PG8_LAS float* xch;
    __device__ __forceinline__ void operator()(const f32x4 (&acc)[2][2][4][2], const Unit& u, int wr, int wc, int fr, int fq) const {
        const int row0 = u.pm * BM + wr * 64 + fr, col0 = u.pn * BM + wc * 32 + 8 * fq;
        const bool isq = u.pn >= 12 && u.pn < 16, isk = u.pn >= 16 && u.pn < 20, isv = u.pn >= 20;
        if (isq || isk) {
#pragma unroll
            for (int ai = 0; ai < 2; ++ai)
#pragma unroll
                for (int m = 0; m < 4; ++m)
#pragma unroll
                    for (int bj = 0; bj < 2; ++bj) { const f32x4 v0 = acc[ai][bj][m][0], v1 = acc[ai][bj][m][1];
                        float ss = ((v0[0] * v0[0] + v0[1] * v0[1]) + (v0[2] * v0[2] + v0[3] * v0[3])) + ((v1[0] * v1[0] + v1[1] * v1[1]) + (v1[2] * v1[2] + v1[3] * v1[3]));
                        ss += __shfl_xor(ss, 16); ss += __shfl_xor(ss, 32);
                        if (fq == 0) xch[((ai * HALF + wr * 64 + m * 16 + fr) * 2 + bj) * 4 + wc] = ss; }
        }
        asm volatile("s_waitcnt lgkmcnt(0)" ::: "memory"); __builtin_amdgcn_s_barrier(); asm volatile("" ::: "memory");
        if (isq || isk) {
            const float* g = isq ? gq : gk; const float gs = isq ? QSCALE : 1.0f; bf16_t* dst = isq ? QN : KN; const int hc0 = (u.pn - (isq ? 12 : 16)) * BM;
            f32x4 g0[2], g1[2];
#pragma unroll
            for (int bj = 0; bj < 2; ++bj) { g0[bj] = *(const f32x4*)(g + wc * 32 + 8 * fq) * gs; g1[bj] = *(const f32x4*)(g + wc * 32 + 8 * fq + 4) * gs; }
#pragma unroll
            for (int ai = 0; ai < 2; ++ai)
#pragma unroll
                for (int m = 0; m < 4; ++m) { const int r = row0 + ai * HALF + m * 16;
#pragma unroll
                    for (int bj = 0; bj < 2; ++bj) { const f32x4 p = *(const PG8_LAS f32x4*)(xch + ((ai * HALF + wr * 64 + m * 16 + fr) * 2 + bj) * 4);
                        const float rstd = 1.0f / sqrtf(((p[0] + p[1]) + (p[2] + p[3])) * (1.0f / 128.0f) + EPS);
                        const f32x4 v0 = acc[ai][bj][m][0] * rstd * g0[bj], v1 = acc[ai][bj][m][1] * rstd * g1[bj];
                        u32x4 w; w.x = cvt_pk_bf16(v0[0], v0[1]); w.y = cvt_pk_bf16(v0[2], v0[3]); w.z = cvt_pk_bf16(v1[0], v1[1]); w.w = cvt_pk_bf16(v1[2], v1[3]);
                        *(u32x4*)(dst + (size_t)r * 1024 + hc0 + bj * HALF + wc * 32 + 8 * fq) = w;
} }
        } else {
#pragma unroll
            for (int ai = 0; ai < 2; ++ai)
#pragma unroll
                for (int m = 0; m < 4; ++m) { const int r = row0 + ai * HALF + m * 16; bf16_t* rowp = O + (size_t)r * ldc + col0;
#pragma unroll
                    for (int bj = 0; bj < 2; ++bj) { const f32x4 v0 = acc[ai][bj][m][0], v1 = acc[ai][bj][m][1];
                        u32x4 w; w.x = cvt_pk_bf16(v0[0], v0[1]); w.y = cvt_pk_bf16(v0[2], v0[3]); w.z = cvt_pk_bf16(v1[0], v1[1]); w.w = cvt_pk_bf16(v1[2], v1[3]);
                        *(u32x4*)(rowp + bj * HALF) = w;
} }
        }
    }
};
struct EpiRes1 {
    static constexpr int REPS = REP_E2; static constexpr bool PERM = false, AFTER_DRAIN = false;
    const float* xp; bf16_t* X1b; float* SSQ;
    __device__ __forceinline__ void operator()(const f32x4 (&acc)[2][2][4][2], const Unit& u, int wr, int wc, int fr, int fq) const {
        const int row0 = u.pm * BM + wr * 64 + fr, col0 = u.pn * BM + wc * 32 + 4 * fq;
#pragma unroll
        for (int ai = 0; ai < 2; ++ai) {
            f32x4 xv[4][2][2];
#pragma unroll
            for (int m = 0; m < 4; ++m)
#pragma unroll
                for (int bj = 0; bj < 2; ++bj)
#pragma unroll
                    for (int n = 0; n < 2; ++n) xv[m][bj][n] = __builtin_nontemporal_load((const f32x4*)(xp + (size_t)(row0 + ai * HALF + m * 16) * DM + col0 + bj * HALF + n * 16));
            asm volatile("" ::: "memory");
#pragma unroll
            for (int m = 0; m < 4; ++m) { const int r = row0 + ai * HALF + m * 16; const size_t off = (size_t)r * DM + col0;
                float ss = 0.f;
#pragma unroll
                for (int bj = 0; bj < 2; ++bj)
#pragma unroll
                    for (int n = 0; n < 2; ++n) { const f32x4 o = xv[m][bj][n] + acc[ai][bj][m][n];
                        ss += (o[0] * o[0] + o[1] * o[1]) + (o[2] * o[2] + o[3] * o[3]);
                        u32x2 pk; pk.x = cvt_pk_bf16(o[0], o[1]); pk.y = cvt_pk_bf16(o[2], o[3]);
                        *(u32x2*)(X1b + off + bj * HALF + n * 16) = pk; }
                ss += __shfl_xor(ss, 16); ss += __shfl_xor(ss, 32);
                if (fq == 0) SSQ[(size_t)r * 32 + u.pn * 4 + wc] = ss; }
        }
    }
};
struct EpiSwiGLU {
    static constexpr int REPS = REP_E3; static constexpr bool PERM = false, AFTER_DRAIN = false;
    const float* SSQ; bf16_t* H;
    __device__ __forceinline__ void operator()(const f32x4 (&acc)[2][2][4][2], const Unit& u, int wr, int wc, int fr, int fq) const {
        const int row0 = u.pm * BM + wr * 64 + fr, col0 = u.pn * HALF + wc * 32 + 8 * fq;
#pragma unroll
        for (int ai = 0; ai < 2; ++ai)
#pragma unroll
            for (int m = 0; m < 4; ++m) { const int r = row0 + ai * HALF + m * 16;
                const f32x4* sp = (const f32x4*)(SSQ + (size_t)r * 32 + fq * 8); const f32x4 a = sp[0], b = sp[1];
                float s = ((a[0] + a[1]) + (a[2] + a[3])) + ((b[0] + b[1]) + (b[2] + b[3]));
                s += __shfl_xor(s, 16); s += __shfl_xor(s, 32);
                const float rstd = __builtin_amdgcn_rsqf(s * (1.0f / DM) + EPS);
                float hv[8];
#pragma unroll
                for (int n = 0; n < 2; ++n)
#pragma unroll
                    for (int j = 0; j < 4; ++j) { const float gt = acc[ai][0][m][n][j] * rstd, up = acc[ai][1][m][n][j] * rstd;
                        hv[n * 4 + j] = gt * up * __builtin_amdgcn_rcpf(1.0f + __expf(-gt)); }
                u32x4 w; w.x = cvt_pk_bf16(hv[0], hv[1]); w.y = cvt_pk_bf16(hv[2], hv[3]); w.z = cvt_pk_bf16(hv[4], hv[5]); w.w = cvt_pk_bf16(hv[6], hv[7]);
                *(u32x4*)(H + (size_t)r * DFF + col0) = w; }
    }
};
struct EpiOut {
    static constexpr int REPS = REP_E4; static constexpr bool PERM = false, AFTER_DRAIN = false;
    const bf16_t* X1b; float* out;
    __device__ __forceinline__ void operator()(const f32x4 (&acc)[2][2][4][2], const Unit& u, int wr, int wc, int fr, int fq) const {
        const int row0 = u.pm * BM + wr * 64 + fr, col0 = u.pn * BM + wc * 32 + 4 * fq;
        u32x2 xw[2][4][2][2];
#pragma unroll
        for (int ai = 0; ai < 2; ++ai)
#pragma unroll
            for (int m = 0; m < 4; ++m)
#pragma unroll
                for (int bj = 0; bj < 2; ++bj)
#pragma unroll
                    for (int n = 0; n < 2; ++n) xw[ai][m][bj][n] = *(const u32x2*)(X1b + (size_t)(row0 + ai * HALF + m * 16) * DM + col0 + bj * HALF + n * 16);
        asm volatile("" ::: "memory");
#pragma unroll
        for (int ai = 0; ai < 2; ++ai)
#pragma unroll
            for (int m = 0; m < 4; ++m) { const size_t off = (size_t)(row0 + ai * HALF + m * 16) * DM + col0;
#pragma unroll
                for (int bj = 0; bj < 2; ++bj)
#pragma unroll
                    for (int n = 0; n < 2; ++n) { const u32x2 w = xw[ai][m][bj][n];
                        const f32x4 xv = (f32x4){__builtin_bit_cast(float, w.x << 16), __builtin_bit_cast(float, w.x & 0xffff0000u), __builtin_bit_cast(float, w.y << 16), __builtin_bit_cast(float, w.y & 0xffff0000u)};
                        __builtin_nontemporal_store(xv + acc[ai][bj][m][n], (f32x4*)(out + off + bj * HALF + n * 16)); } }
    }
};

template <class Epi, class Sched, bool ALIGN_EPI = false, bool SP2 = false>
__device__ __forceinline__ void gemm_phase(PG8_LAS unsigned char* lds, const Gemm g, const Sched& S, const Epi& E) {
    int tid_ = threadIdx.x; asm volatile("" : "+v"(tid_));
    const int tid = tid_, wid = __builtin_amdgcn_readfirstlane(tid >> 6), lane = tid & 63, wr = wid >> 2, wc = wid & 3, fr = lane & 15, fq = lane >> 4;
    const int K = g.K, nt = K / BK;
    unsigned voffA[2], voffB[2];
#pragma unroll
    for (int i = 0; i < 2; ++i) { int R, C;
#if PG8_ROWMAJOR
        { const int b_ = tid * 16 + i * 8192; R = b_ >> 7; C = 8 * (((b_ >> 4) & 7) ^ ((R >> 1) & 7)); }
#else
        stage_rc(tid * 16 + i * 8192, R, C);
#endif
        const int Rb = Epi::PERM ? ((R & ~31) + perm32(R & 31)) : R;
        voffA[i] = (unsigned)(R * K + C) * 2u; voffB[i] = (unsigned)(Rb * K + C) * 2u; }
    const size_t kstep = (size_t)(BK * 2);
    const size_t hstep = (size_t)HALF * K * 2;
    const size_t tstep = 2 * hstep;
    const unsigned ldsw = (unsigned)wid * 1024u;
#if PG8_ROWMAJOR
    const int aoff = (wr * 64 + fr) * 128 + 16 * (fq ^ ((fr >> 1) & 7)), boff = (wc * 32 + fr) * 128 + 16 * (fq ^ ((fr >> 1) & 7));
#define PG8_KOFF(base, k) ((base) ^ ((k) * 64))
#else
    const int aoff = lds_byte(wr * 64 + fr, fq * 8), boff = lds_byte(wc * 32 + fr, fq * 8);
#define PG8_KOFF(base, k) ((base) + (k) * 1024)
#endif
#define PG8_SA(b, h) (((b) * 2 + (h)) * HTB)
#define PG8_SB(b, h) ((4 + (b) * 2 + (h)) * HTB)
#define PG8_STAGE(bufoff, gbase, voff) do { _Pragma("unroll") for (int _i = 0; _i < 2; ++_i) \
        __builtin_amdgcn_global_load_lds((const unsigned*)((const char*)(gbase) + (voff)[_i]), (PG8_LAS unsigned*)(lds + (bufoff) + ldsw + _i * 8192), 16, 0, 0); } while (0)
#define PG8_LDA(dst, b, h) do { _Pragma("unroll") for (int m = 0; m < 4; ++m) _Pragma("unroll") for (int k = 0; k < 2; ++k) dst[m][k] = *(const PG8_LAS bf16x8*)(lds + PG8_SA(b, h) + PG8_KOFF(aoff, k) + m * 2048); } while (0)
#define PG8_LDB(dst, b, h) do { _Pragma("unroll") for (int n = 0; n < 2; ++n) _Pragma("unroll") for (int k = 0; k < 2; ++k) dst[n][k] = *(const PG8_LAS bf16x8*)(lds + PG8_SB(b, h) + PG8_KOFF(boff, k) + n * 2048); } while (0)
#define PG8_MMA(ai, bj, At, Bt) do { __builtin_amdgcn_s_setprio(1); _Pragma("unroll") for (int m = 0; m < 4; ++m) _Pragma("unroll") for (int n = 0; n < 2; ++n) _Pragma("unroll") for (int k = 0; k < 2; ++k) \
        acc[ai][bj][m][n] = __builtin_amdgcn_mfma_f32_16x16x32_bf16(Bt[n][k], At[m][k], acc[ai][bj][m][n], 0, 0, 0); __builtin_amdgcn_s_setprio(0); } while (0)
#define PG8_WAIT_V(n) asm volatile("s_waitcnt vmcnt(" #n ")" ::: "memory")
#define PG8_WAIT_L(n) asm volatile("s_waitcnt lgkmcnt(" #n ")" ::: "memory")
#define PG8_BAR __builtin_amdgcn_s_barrier()
#define PG8_SCHED __builtin_amdgcn_sched_barrier(0)
    Unit cur, nxt; int ui = 0;
    if (!S.next(0, cur)) return;
    f32x4 acc[2][2][4][2];
#pragma unroll
    for (int a = 0; a < 2; ++a)
#pragma unroll
        for (int b = 0; b < 2; ++b)
#pragma unroll
            for (int m = 0; m < 4; ++m)
#pragma unroll
                for (int n = 0; n < 2; ++n) acc[a][b][m][n] = (f32x4){0.f, 0.f, 0.f, 0.f};
    bf16x8 At[4][2], B0[2][2], B1[2][2];
    const char* cA = (const char*)g.A + (size_t)cur.pm * tstep; const char* cB = (const char*)g.Bt + (size_t)cur.pn * tstep;
    S.a_ready(cur);
    if constexpr (SP2) {
        PG8_STAGE(PG8_SB(0, 0), cB, voffB); PG8_STAGE(PG8_SB(0, 1), cB + hstep, voffB); PG8_STAGE(PG8_SA(0, 0), cA, voffA); PG8_STAGE(PG8_SA(0, 1), cA + hstep, voffA);
        if (wr == 1) PG8_BAR;
        PG8_WAIT_V(2); PG8_BAR;
        PG8_STAGE(PG8_SB(1, 0), cB + kstep, voffB); PG8_STAGE(PG8_SA(1, 0), cA + kstep, voffA); PG8_STAGE(PG8_SB(1, 1), cB + hstep + kstep, voffB);
        PG8_WAIT_V(6); PG8_BAR;
    } else {
        PG8_STAGE(PG8_SB(0, 0), cB, voffB); PG8_STAGE(PG8_SA(0, 0), cA, voffA); PG8_STAGE(PG8_SB(0, 1), cB + hstep, voffB); PG8_STAGE(PG8_SA(0, 1), cA + hstep, voffA);
        if (wr == 1) PG8_BAR;
        PG8_WAIT_V(4); PG8_BAR;
        PG8_STAGE(PG8_SB(1, 0), cB + kstep, voffB); PG8_STAGE(PG8_SA(1, 0), cA + kstep, voffA); PG8_STAGE(PG8_SB(1, 1), cB + hstep + kstep, voffB);
        PG8_WAIT_V(6); PG8_BAR;
    }
    for (;;) {
        const bool has_next = S.next(ui + 1, nxt);
        const char* nA = has_next ? (const char*)g.A + (size_t)nxt.pm * tstep : cA; const char* nB = has_next ? (const char*)g.Bt + (size_t)nxt.pn * tstep : cB;
        for (int t = 0; t < nt; t += 2) {
            const bool last = (t == nt - 2);
            const char* a1 = cA + (size_t)(t + 1) * kstep;
            const char* a2 = last ? nA : cA + (size_t)(t + 2) * kstep; const char* b2 = last ? nB : cB + (size_t)(t + 2) * kstep;
            const char* a3 = a2 + kstep; const char* b3 = b2 + kstep;
            if (last && has_next) S.a_ready(nxt);
            if constexpr (SP2) {
            PG8_LDB(B0, 0, 0); PG8_LDB(B1, 0, 1); PG8_SCHED; PG8_LDA(At, 0, 0); PG8_STAGE(PG8_SA(1, 1), a1 + hstep, voffA);
            PG8_WAIT_V(8); PG8_WAIT_L(0); PG8_BAR; PG8_MMA(0, 0, At, B0); PG8_MMA(0, 1, At, B1); PG8_BAR; PG8_SCHED;
            PG8_LDA(At, 0, 1); PG8_STAGE(PG8_SB(0, 0), b2, voffB); PG8_STAGE(PG8_SB(0, 1), b2 + hstep, voffB); PG8_STAGE(PG8_SA(0, 0), a2, voffA);
            PG8_WAIT_V(8); PG8_WAIT_L(0); PG8_BAR; PG8_MMA(1, 0, At, B0); PG8_MMA(1, 1, At, B1); PG8_BAR; PG8_SCHED;
            PG8_LDB(B0, 1, 0); PG8_LDB(B1, 1, 1); PG8_SCHED; PG8_LDA(At, 1, 0); PG8_STAGE(PG8_SA(0, 1), a2 + hstep, voffA);
            PG8_WAIT_V(8); PG8_WAIT_L(0); PG8_BAR; PG8_MMA(0, 0, At, B0); PG8_MMA(0, 1, At, B1); PG8_BAR; PG8_SCHED;
            PG8_LDA(At, 1, 1); PG8_STAGE(PG8_SB(1, 0), b3, voffB); PG8_STAGE(PG8_SB(1, 1), b3 + hstep, voffB); PG8_STAGE(PG8_SA(1, 0), a3, voffA);
            PG8_WAIT_V(8); PG8_WAIT_L(0); PG8_BAR; PG8_MMA(1, 0, At, B0); PG8_MMA(1, 1, At, B1); PG8_BAR; PG8_SCHED;
            } else {
            PG8_LDB(B0, 0, 0); PG8_SCHED; PG8_LDA(At, 0, 0); PG8_STAGE(PG8_SA(1, 1), a1 + hstep, voffA);
            PG8_WAIT_L(8); PG8_BAR; PG8_WAIT_L(0); PG8_MMA(0, 0, At, B0); PG8_BAR; PG8_SCHED;
            PG8_LDB(B1, 0, 1); PG8_STAGE(PG8_SB(0, 0), b2, voffB);
            PG8_BAR; PG8_WAIT_L(0); PG8_MMA(0, 1, At, B1); PG8_BAR;
            PG8_LDA(At, 0, 1); PG8_STAGE(PG8_SA(0, 0), a2, voffA);
            PG8_BAR; PG8_WAIT_L(0); PG8_MMA(1, 0, At, B0); PG8_BAR; PG8_SCHED;
            PG8_STAGE(PG8_SB(0, 1), b2 + hstep, voffB);
            PG8_WAIT_V(6); PG8_BAR; PG8_MMA(1, 1, At, B1); PG8_BAR;
            PG8_LDB(B0, 1, 0); PG8_SCHED; PG8_LDA(At, 1, 0); PG8_STAGE(PG8_SA(0, 1), a2 + hstep, voffA);
            PG8_WAIT_L(8); PG8_BAR; PG8_WAIT_L(0); PG8_MMA(0, 0, At, B0); PG8_BAR; PG8_SCHED;
            PG8_LDB(B1, 1, 1); PG8_STAGE(PG8_SB(1, 0), b3, voffB);
            PG8_BAR; PG8_WAIT_L(0); PG8_MMA(0, 1, At, B1); PG8_BAR;
            PG8_LDA(At, 1, 1); PG8_STAGE(PG8_SA(1, 0), a3, voffA);
            PG8_BAR; PG8_WAIT_L(0); PG8_MMA(1, 0, At, B0); PG8_BAR; PG8_SCHED;
            PG8_STAGE(PG8_SB(1, 1), b3 + hstep, voffB);
            PG8_WAIT_V(6); PG8_BAR; PG8_MMA(1, 1, At, B1); PG8_BAR;
            }
        }
        if constexpr (ALIGN_EPI) { if (wr == 0) PG8_BAR; }
        if constexpr (!Epi::AFTER_DRAIN) { E(acc, cur, wr, wc, fr, fq); if constexpr (Epi::REPS > 1) { asm volatile("" ::: "memory"); Unit c2 = cur; int fr2 = fr, fq2 = fq; asm volatile("" : "+s"(c2.pm), "+s"(c2.pn), "+v"(fr2), "+v"(fq2)); E(acc, c2, wr, wc, fr2, fq2); } S.done(cur); }
        if (!has_next) break;
#pragma unroll
        for (int a = 0; a < 2; ++a)
#pragma unroll
            for (int b = 0; b < 2; ++b)
#pragma unroll
                for (int m = 0; m < 4; ++m)
#pragma unroll
                    for (int n = 0; n < 2; ++n) acc[a][b][m][n] = (f32x4){0.f, 0.f, 0.f, 0.f};
        cur = nxt; cA = nA; cB = nB; ++ui;
        if constexpr (ALIGN_EPI) { if (wr == 1) PG8_BAR; }
    }
    PG8_WAIT_V(0);
    if constexpr (!ALIGN_EPI) { if (wr == 0) PG8_BAR; }
    PG8_BAR;
#undef PG8_SA
#undef PG8_KOFF
#undef PG8_SB
#undef PG8_STAGE
#undef PG8_LDA
#undef PG8_LDB
#undef PG8_MMA
#undef PG8_WAIT_V
#undef PG8_WAIT_L
#undef PG8_BAR
#undef PG8_SCHED
}
}

#define GAS __attribute__((address_space(1)))
#define LAS __attribute__((address_space(3)))
typedef unsigned short bf16;
typedef unsigned v4u __attribute__((ext_vector_type(4)));
typedef unsigned v2u __attribute__((ext_vector_type(2)));
typedef float f32x4 __attribute__((ext_vector_type(4)));
typedef float f32x2 __attribute__((ext_vector_type(2)));
#define LDS_WAIT() asm volatile("s_waitcnt lgkmcnt(0)" ::: "memory")
constexpr int NWAVES = 8, NTHR = 512;
constexpr int LDS_BYTES = 160 * 1024;
constexpr int LDS_ST_OFF = LDS_BYTES - 64;

__device__ __forceinline__ int opaque_tid() { int t = threadIdx.x; asm volatile("" : "+v"(t)); return t; }
__device__ __forceinline__ unsigned f2bf(float f) { unsigned u = __builtin_bit_cast(unsigned, f); return (u + 0x7fffu + ((u >> 16) & 1u)) >> 16; }
__device__ __forceinline__ unsigned pk2(float lo, float hi) { unsigned r; asm volatile("v_cvt_pk_bf16_f32 %0, %1, %2" : "=v"(r) : "v"(lo), "v"(hi)); return r; }
__device__ __forceinline__ float bf_lo(unsigned w) { return __builtin_bit_cast(float, w << 16); }
__device__ __forceinline__ float bf_hi(unsigned w) { return __builtin_bit_cast(float, w & 0xffff0000u); }
__device__ __forceinline__ float wave_sum(float v) {
#pragma unroll
    for (int o = 1; o < 64; o <<= 1) v += __shfl_xor(v, o);
    return v;
}
__device__ __forceinline__ float wave_max(float v) {
#pragma unroll
    for (int o = 1; o < 64; o <<= 1) v = fmaxf(v, __shfl_xor(v, o));
    return v;
}

constexpr size_t MiB = 1u << 20;
constexpr size_t WS_CTL = 0;
constexpr size_t WS_WIN = 1 * MiB;
constexpr size_t WS_WOUT = 25 * MiB;
constexpr size_t WS_WGU = 33 * MiB;
constexpr size_t WS_WDN = 77 * MiB;
constexpr size_t WS_XN = 99 * MiB;
constexpr size_t WS_PROJ = 132 * MiB;
constexpr size_t WS_QN = 231 * MiB;
constexpr size_t WS_KN = 248 * MiB;
constexpr size_t WS_VT1 = 265 * MiB, WS_VT2 = 281 * MiB, WS_VT3 = 297 * MiB;
constexpr size_t WS_MIX = 313 * MiB;
constexpr size_t WS_X1 = 346 * MiB;
constexpr size_t WS_XN2 = 412 * MiB;
constexpr size_t WS_SSQ = 445 * MiB;
constexpr size_t WS_H = 447 * MiB;
constexpr size_t WS_END = 538 * MiB;

constexpr size_t O_Y = 0;
constexpr size_t O_PK = (size_t)MT * DM;
constexpr size_t O_PV = O_PK + (size_t)2048 * 1024;
constexpr size_t O_PC = O_PV + (size_t)2048 * 1024;
constexpr size_t O_SK = O_PC + 2048;
constexpr size_t O_SV = O_SK + (size_t)NSAMP * 1024;
constexpr size_t O_SC = O_SV + (size_t)NSAMP * 1024;
constexpr size_t O_END = O_SC + (size_t)DBATCH * 2 * 1024;

struct Args {
    const float* x_prompt; const float* x_sample; const float* cache_k; const float* cache_v; const float* state_conv; const float* norm_mix; const float* w_in; const float* conv_w;
    const float* q_norm; const float* k_norm; const float* rel_bias; const float* w_out; const float* norm_ffn; const float* w_gate; const float* w_up; const float* w_down;
    float* out; unsigned char* ws;
};

__device__ __forceinline__ void p0_transpose_item(const float* W, int N, int K, int c0, int k0, bf16* WT, int drow0, bool perm, LAS float* scr, int lane, const float* kscale = nullptr) {
    const int ksub = lane >> 4, n4 = lane & 15;
    f32x4 v[16];
    const GAS f32x4* src = (const GAS f32x4*)(W + (size_t)(k0 + ksub) * N + c0 + 4 * n4);
#pragma unroll
    for (int i = 0; i < 16; ++i) v[i] = __builtin_nontemporal_load(src + (size_t)i * N);
    if (kscale) {
#pragma unroll
        for (int i = 0; i < 16; ++i) v[i] = v[i] * kscale[k0 + 4 * i + ksub]; }
#pragma unroll
    for (int i = 0; i < 16; ++i) { LAS float* d = scr + (4 * i + ksub) * 65 + 4 * n4; d[0] = v[i][0]; d[1] = v[i][1]; d[2] = v[i][2]; d[3] = v[i][3]; }
    LDS_WAIT(); asm volatile("" ::: "memory");
    const int c = lane >> 3, nsub = lane & 7;
#pragma unroll
    for (int j = 0; j < 8; ++j) { const int n = nsub + 8 * j; const int ns = perm ? ((n & 32) + pg8::perm32(n & 31)) : n; const LAS float* s = scr + (8 * c) * 65 + ns;
        v4u o; o.x = pk2(s[0 * 65], s[1 * 65]); o.y = pk2(s[2 * 65], s[3 * 65]); o.z = pk2(s[4 * 65], s[5 * 65]); o.w = pk2(s[6 * 65], s[7 * 65]);
        *(GAS v4u*)(WT + (size_t)(drow0 + n) * K + k0 + 8 * c) = o; }
    LDS_WAIT(); asm volatile("" ::: "memory");
}
__device__ __forceinline__ void p0_rms_row(const float* xrow, const float* g, bf16* orow, int lane) {
    const GAS f32x4* xr = (const GAS f32x4*)xrow + lane; const GAS f32x4* gr = (const GAS f32x4*)g + lane;
    f32x4 v[8]; float s = 0.f;
#pragma unroll
    for (int j = 0; j < 8; ++j) { v[j] = __builtin_nontemporal_load(xr + 64 * j); s += (v[j].x * v[j].x + v[j].y * v[j].y) + (v[j].z * v[j].z + v[j].w * v[j].w); }
    const float rstd = 1.0f / sqrtf(wave_sum(s) * (1.f / DM) + EPS);
    GAS v2u* o8 = (GAS v2u*)orow + lane;
#pragma unroll
    for (int j = 0; j < 8; ++j) { const f32x4 gg = gr[64 * j]; v2u o; o.x = pk2(v[j].x * rstd * gg.x, v[j].y * rstd * gg.y); o.y = pk2(v[j].z * rstd * gg.z, v[j].w * rstd * gg.w); o8[64 * j] = o; }
}
__device__ __forceinline__ void phase_prologue(const Args& A, LAS unsigned char* lds, int vcu, int G) {
    const int tid = opaque_tid(), lane = tid & 63, wave = __builtin_amdgcn_readfirstlane(tid >> 6);
    LAS float* scr = (LAS float*)(lds + wave * 17408);
    const int gw = vcu * NWAVES + wave, NGW = G * NWAVES;
    bf16* WIN = (bf16*)(A.ws + WS_WIN); bf16* WOUT = (bf16*)(A.ws + WS_WOUT); bf16* WGU = (bf16*)(A.ws + WS_WGU); bf16* WDN = (bf16*)(A.ws + WS_WDN); bf16* XN = (bf16*)(A.ws + WS_XN);
    constexpr int I_IN = (DM / 64) * (DIN / 64), I_OUT = (DM / 64) * (DM / 64), I_GU = (DM / 64) * (NGU / 64), I_DN = (DFF / 64) * (DM / 64);
    constexpr int NITEMS = I_IN;
    for (int it = gw; it < NITEMS; it += NGW) { const int nb = it % (DIN / 64), kb = it / (DIN / 64); p0_transpose_item(A.w_in, DIN, DM, 64 * nb, 64 * kb, WIN, 64 * nb, false, scr, lane); }
    for (int m = gw; m < MT; m += NGW) p0_rms_row(m < SEQ ? A.x_prompt + (size_t)m * DM : A.x_sample + (size_t)(m - SEQ) * DM, A.norm_mix, XN + (size_t)m * DM, lane);
}
constexpr int PL_WO = (DM / 64) * (DM / 64) / 8, PL_GU = PL_WO + (DM / 64) * (NGU / 64) / 8;
__device__ __forceinline__ void convert_gu_item(const Args& A, LAS unsigned char* lds, int item) {
    const int tid = opaque_tid(), lane = tid & 63, wave = __builtin_amdgcn_readfirstlane(tid >> 6);
    LAS float* scr = (LAS float*)(lds + wave * 17408);
    bf16* WGU = (bf16*)(A.ws + WS_WGU);
    if (item < PL_WO) { const int r = item * 8 + wave; const int nb = r % (DM / 64), kb = r / (DM / 64); p0_transpose_item(A.w_out, DM, DM, 64 * nb, 64 * kb, (bf16*)(A.ws + WS_WOUT), 64 * nb, false, scr, lane); return; }
    item -= PL_WO;
    { const int r = item * 8 + wave; const int nb = r % (NGU / 64), kb = r / (NGU / 64);
        const int pn = nb >> 2, t = (nb >> 1) & 1, w2 = nb & 1; p0_transpose_item(t ? A.w_up : A.w_gate, DFF, DM, 128 * pn + 64 * w2, 64 * kb, WGU, 64 * nb, true, scr, lane, A.norm_ffn); }
}
__device__ __forceinline__ void convert_wdown(const Args& A, LAS unsigned char* lds, int widx, int nw) {
    const int tid = opaque_tid(), lane = tid & 63, wave = __builtin_amdgcn_readfirstlane(tid >> 6);
    LAS float* scr = (LAS float*)(lds + wave * 17408);
    bf16* WDN = (bf16*)(A.ws + WS_WDN);
    constexpr int I_DN = (DFF / 64) * (DM / 64);
    for (int r = widx * NWAVES + wave; r < I_DN; r += nw * NWAVES) { const int nb = r % (DM / 64), kb = r / (DM / 64); p0_transpose_item(A.w_down, DM, DFF, 64 * nb, 64 * kb, WDN, 64 * nb, false, scr, lane); }
}

__device__ __forceinline__ void unpack8(const v4u w, float* f) { f[0] = bf_lo(w.x); f[1] = bf_hi(w.x); f[2] = bf_lo(w.y); f[3] = bf_hi(w.y); f[4] = bf_lo(w.z); f[5] = bf_hi(w.z); f[6] = bf_lo(w.w); f[7] = bf_hi(w.w); }
__device__ __forceinline__ float softmax_bound_l2(const Args& A, int lane) {
    float mq = fmaxf(fabsf(A.q_norm[lane]), fabsf(A.q_norm[lane + 64])), mk = fmaxf(fabsf(A.k_norm[lane]), fabsf(A.k_norm[lane + 64]));
    float mb = fmaxf(fmaxf(fabsf(A.rel_bias[lane]), fabsf(A.rel_bias[lane + 64])), fmaxf(fabsf(A.rel_bias[lane + 128]), fabsf(A.rel_bias[lane + 192])));
    mq = wave_max(mq); mk = wave_max(mk); mb = wave_max(mb);
    return LOG2E * (11.313708498984761f * mq * mk * 1.01f + mb);
}
typedef short bf16x8 __attribute__((ext_vector_type(8)));
__device__ __forceinline__ bf16x8 ld16(const bf16* p) { return __builtin_bit_cast(bf16x8, *(const GAS v4u*)p); }
typedef short s16x4 __attribute__((ext_vector_type(4)));
constexpr int AT_STAGE = 65536, AT_VOFF = 32768, AT_TBL = 131072;
__device__ __forceinline__ int swz_f(int row) { return (((row ^ (row >> 2) ^ (row >> 4)) & 1) << 1) | ((((row >> 1) ^ (row >> 5)) & 1) << 2) | ((((row >> 3) ^ (row >> 6)) & 1) << 3); }
__device__ __forceinline__ void attn2_stage(LAS unsigned char* lds, int buf, const bf16* Kg, const bf16* Vg, int P0, int wave, int lane) {
#pragma unroll
    for (int i = 0; i < 4; ++i) { const int row = (wave * 4 + i) * 4 + (lane >> 4), c = (lane & 15) ^ swz_f(row);
        __builtin_amdgcn_global_load_lds((const unsigned*)(Kg + (size_t)(P0 + row) * 1024 + 8 * c), (LAS unsigned*)(lds + buf * AT_STAGE + (wave * 4 + i) * 1024), 16, 0, 0); }
#pragma unroll
    for (int i = 0; i < 4; ++i) { const int row = (wave * 4 + i) * 4 + (lane >> 4), c = (lane & 15) ^ swz_f(row);
        __builtin_amdgcn_global_load_lds((const unsigned*)(Vg + (size_t)(P0 + row) * DIN + 8 * c), (LAS unsigned*)(lds + buf * AT_STAGE + AT_VOFF + (wave * 4 + i) * 1024), 16, 0, 0); }
}
template <bool HALF, int CX, int OFF>
__device__ __forceinline__ void attn5_block(const LAS unsigned char* Kb, const LAS unsigned char* Vb, unsigned ko0, unsigned ko1, unsigned voA, unsigned voB, const bf16x8 (&qf)[4], f32x4 (&o)[8], float& lsum, const LAS float* tj) {
    f32x4 s0 = (f32x4){tj[0], tj[-1], tj[-2], tj[-3]}, s1 = HALF ? (f32x4){0.f, 0.f, 0.f, 0.f} : (f32x4){tj[-4], tj[-5], tj[-6], tj[-7]};
    {   bf16x8 kf0[4];
#pragma unroll
        for (int ks = 0; ks < 4; ++ks) kf0[ks] = *(const LAS bf16x8*)(Kb + (ko0 ^ (unsigned)(64 * ks ^ CX)) + OFF);
        if (!HALF) { bf16x8 kf1[4];
#pragma unroll
            for (int ks = 0; ks < 4; ++ks) kf1[ks] = *(const LAS bf16x8*)(Kb + (ko1 ^ (unsigned)(64 * ks ^ CX)) + OFF);
#pragma unroll
            for (int ks = 0; ks < 4; ++ks) { s0 = __builtin_amdgcn_mfma_f32_16x16x32_bf16(kf0[ks], qf[ks], s0, 0, 0, 0); s1 = __builtin_amdgcn_mfma_f32_16x16x32_bf16(kf1[ks], qf[ks], s1, 0, 0, 0); }
        } else {
#pragma unroll
            for (int ks = 0; ks < 4; ++ks) s0 = __builtin_amdgcn_mfma_f32_16x16x32_bf16(kf0[ks], qf[ks], s0, 0, 0, 0);
        }
    }
    float pv[8];
#pragma unroll
    for (int e = 0; e < (HALF ? 4 : 8); ++e) { const float sv = e < 4 ? s0[e] : s1[e - 4]; pv[e] = __builtin_amdgcn_exp2f(sv); lsum += pv[e]; }
    v4u pw; pw.x = pg8::cvt_pk_bf16(pv[0], pv[1]); pw.y = pg8::cvt_pk_bf16(pv[2], pv[3]);
    if (HALF) { pw.z = 0u; pw.w = 0u; } else { pw.z = pg8::cvt_pk_bf16(pv[4], pv[5]); pw.w = pg8::cvt_pk_bf16(pv[6], pv[7]); }
    const bf16x8 pf = __builtin_bit_cast(bf16x8, pw);
    const unsigned vA = (unsigned)(size_t)Vb + voA, vB = (unsigned)(size_t)Vb + voB;
    s16x4 va[8], vb[8];
#pragma unroll
    for (int dt = 0; dt < 8; ++dt) {
        asm volatile("ds_read_b64_tr_b16 %0, %1 offset:%2" : "=v"(va[dt]) : "v"(vA ^ (unsigned)(32 * dt ^ CX)), "i"(OFF));
        if (!HALF) asm volatile("ds_read_b64_tr_b16 %0, %1 offset:%2" : "=v"(vb[dt]) : "v"(vB ^ (unsigned)(32 * dt ^ CX)), "i"(OFF));
        else vb[dt] = (s16x4){0, 0, 0, 0};
    }
    if (!HALF) asm volatile("s_waitcnt lgkmcnt(0)" : "+v"(va[0]), "+v"(va[1]), "+v"(va[2]), "+v"(va[3]), "+v"(va[4]), "+v"(va[5]), "+v"(va[6]), "+v"(va[7]), "+v"(vb[0]), "+v"(vb[1]), "+v"(vb[2]), "+v"(vb[3]), "+v"(vb[4]), "+v"(vb[5]), "+v"(vb[6]), "+v"(vb[7]) :: "memory");
    else asm volatile("s_waitcnt lgkmcnt(0)" : "+v"(va[0]), "+v"(va[1]), "+v"(va[2]), "+v"(va[3]), "+v"(va[4]), "+v"(va[5]), "+v"(va[6]), "+v"(va[7]) :: "memory");
    __builtin_amdgcn_sched_barrier(0);
#pragma unroll
    for (int dt = 0; dt < 8; ++dt) {
        const bf16x8 vf = (bf16x8){va[dt][0], va[dt][1], va[dt][2], va[dt][3], vb[dt][0], vb[dt][1], vb[dt][2], vb[dt][3]};
        o[dt] = __builtin_amdgcn_mfma_f32_16x16x32_bf16(vf, pf, o[dt], 0, 0, 0);
    }
}
__device__ __forceinline__ const LAS float* tbl_at(const LAS float* tb, int jb) { const int jc = jb < -1 ? -1 : (jb > 137 ? 137 : jb); return tb + jc; }
template <int BUF>
__device__ __forceinline__ void attn2_chunk(LAS unsigned char* lds, const bf16* Kg, const bf16* Vg, int t0, int j, int r0, int wave, int lane, const bf16x8 (&qf)[2][4], f32x4 (&o)[2][8], float (&lsum)[2]) {
    const int Pj = t0 - 2048 + 128 * j;
    if (j + 1 < 18) attn2_stage(lds, BUF ^ 1, Kg, Vg, Pj + 128, wave, lane);
    asm volatile("" ::: "memory");
    const LAS unsigned char* Kb = lds + BUF * AT_STAGE; const LAS unsigned char* Vb = lds + BUF * AT_STAGE + AT_VOFF;
    const LAS float* tbl = (const LAS float*)(lds + AT_TBL);
#pragma unroll
    for (int gi = 0; gi < 2; ++gi) { const int r = r0 + gi;
        int l2 = lane; asm volatile("" : "+v"(l2));
        const int li2 = l2 & 15, qd2 = l2 >> 4, q2 = li2 >> 2, p2 = li2 & 3; const unsigned pt = 8u * (p2 & 1);
        {
            const int row = r + 16 * (li2 & 7), rowA = r + 16 * ((4 * qd2 + q2) & 7);
            const unsigned ko0 = row * 256 + 16 * (qd2 ^ swz_f(row)), voA = rowA * 256 + 16 * ((p2 >> 1) ^ swz_f(rowA)) + pt;
            attn5_block<true, 0, 0>(Kb, Vb, ko0, 0u, voA, 0u, qf[gi], o[gi], lsum[gi], tbl_at(tbl + 2 * 148 + 8, qd2 < 2 ? ((t0 - Pj) >> 4) + li2 - 4 * qd2 : 100000)); }
        if (j >= 12) {
            const int row0 = (r & 3) + 4 * (8 * q2 + p2), row1 = row0 + 16, rowA = (r & 3) + 4 * (8 * qd2 + q2), rowB = rowA + 16;
            const unsigned ko0 = row0 * 256 + 16 * (qd2 ^ swz_f(row0)), ko1 = row1 * 256 + 16 * (qd2 ^ swz_f(row1)), voA = rowA * 256 + 16 * ((p2 >> 1) ^ swz_f(rowA)) + pt, voB = rowB * 256 + 16 * ((p2 >> 1) ^ swz_f(rowB)) + pt;
            attn5_block<false, 0, 0>(Kb, Vb, ko0, ko1, voA, voB, qf[gi], o[gi], lsum[gi], tbl_at(tbl + 148 + 8, ((t0 - Pj) >> 2) + (r >> 2) + 4 * li2 - 8 * qd2)); }
        if (j >= 15) {
            const int row0 = 8 * q2 + p2, row1 = row0 + 4, rowA = 8 * qd2 + q2, rowB = rowA + 4;
            const unsigned ko0 = row0 * 256 + 16 * (qd2 ^ swz_f(row0)), ko1 = row1 * 256 + 16 * (qd2 ^ swz_f(row1)), voA = rowA * 256 + 16 * ((p2 >> 1) ^ swz_f(rowA)) + pt, voB = rowB * 256 + 16 * ((p2 >> 1) ^ swz_f(rowB)) + pt;
            const int jb0 = (t0 - Pj) + r + 16 * li2 - 8 * qd2; const LAS float* tb1 = tbl + 8;
            attn5_block<false, 0, 0>(Kb, Vb, ko0, ko1, voA, voB, qf[gi], o[gi], lsum[gi], tbl_at(tb1, jb0));
            attn5_block<false, 64, 8192>(Kb, Vb, ko0, ko1, voA, voB, qf[gi], o[gi], lsum[gi], tbl_at(tb1, jb0 - 32));
            attn5_block<false, 128, 16384>(Kb, Vb, ko0, ko1, voA, voB, qf[gi], o[gi], lsum[gi], tbl_at(tb1, jb0 - 64));
            attn5_block<false, 192, 24576>(Kb, Vb, ko0, ko1, voA, voB, qf[gi], o[gi], lsum[gi], tbl_at(tb1, jb0 - 96)); }
    }
    asm volatile("s_waitcnt vmcnt(0) lgkmcnt(0)" ::: "memory");
    __builtin_amdgcn_s_barrier(); asm volatile("" ::: "memory");
}
constexpr int FR_SLOT = 4096, FR_WAVE = 4 * FR_SLOT;
__device__ __forceinline__ void far_stage(LAS unsigned char* ring, int slot, const bf16* Kg, const bf16* Vg, int pos0, int lane) {
#pragma unroll
    for (int i = 0; i < 4; ++i) { const int row = 4 * (i & 1) + (lane >> 4), c = (lane & 15) ^ (2 * row);
        const bf16* src = (i < 2 ? Kg + (size_t)(pos0 + 16 * row) * 1024 : Vg + (size_t)(pos0 + 16 * row) * DIN) + 8 * c;
        __builtin_amdgcn_global_load_lds((const unsigned*)src, (LAS unsigned*)(ring + slot * FR_SLOT + i * 1024), 16, 0, 0); }
}
template <int S>
__device__ __forceinline__ void far_step(LAS unsigned char* lds, LAS unsigned char* ring, const bf16* Kg, const bf16* Vg, int t0, int jmin, int r0, int gc, int ngc, int lane, const bf16x8 (&qf)[2][4], f32x4 (&o)[2][8], float (&lsum)[2]) {
    constexpr int gi = S & 1;
    if (gc + 3 < ngc) { const int x = gc + 3; far_stage(ring, (S + 3) & 3, Kg, Vg, t0 - 2048 + 128 * (jmin + (x >> 1)) + r0 + (x & 1), lane); asm volatile("s_waitcnt vmcnt(12)" ::: "memory"); }
    else if (gc + 2 < ngc) asm volatile("s_waitcnt vmcnt(8)" ::: "memory");
    else if (gc + 1 < ngc) asm volatile("s_waitcnt vmcnt(4)" ::: "memory");
    else asm volatile("s_waitcnt vmcnt(0)" ::: "memory");
    const int Pj = t0 - 2048 + 128 * (jmin + (gc >> 1));
    int l2 = lane; asm volatile("" : "+v"(l2));
    const int li2 = l2 & 15, qd2 = l2 >> 4, q2 = li2 >> 2, p2 = li2 & 3, k = li2 & 7, kA = (4 * qd2 + q2) & 7;
    const unsigned ko0 = k * 256 + 16 * (qd2 ^ (2 * k)), voA = kA * 256 + 16 * ((p2 >> 1) ^ (2 * kA)) + 8u * (p2 & 1);
    const LAS unsigned char* Kb = ring + S * FR_SLOT;
    attn5_block<true, 0, 0>(Kb, Kb + 2048, ko0, 0u, voA, 0u, qf[gi], o[gi], lsum[gi], tbl_at((const LAS float*)(lds + AT_TBL) + 2 * 148 + 8, qd2 < 2 ? ((t0 - Pj) >> 4) + li2 - 4 * qd2 : 100000));
    asm volatile("s_waitcnt lgkmcnt(0)" ::: "memory");
}
__device__ __forceinline__ void attn2_prompt_unit(const Args& A, LAS unsigned char* lds, int h, int qt, float Mp) {
    const int tid = opaque_tid(), lane = tid & 63, wave = __builtin_amdgcn_readfirstlane(tid >> 6), li = lane & 15, quad = lane >> 4;
    const bf16* QN = (const bf16*)(A.ws + WS_QN); bf16* MIX = (bf16*)(A.ws + WS_MIX);
    const bf16* Kg = (const bf16*)(A.ws + WS_KN) + h * HD; const bf16* Vg = (const bf16*)(A.ws + WS_PROJ) + 5120 + h * HD;
    LAS float* tbl = (LAS float*)(lds + AT_TBL);
    __syncthreads();
    for (int x = tid; x < 3 * 148; x += NTHR) { const int g = x / 148, jj = x % 148 - 8; float v = -1e30f; if (jj >= 0 && jj <= 128) v = A.rel_bias[BUCKET[g][jj] * NH + h] * LOG2E - Mp; tbl[x] = v; }
    const int t0 = qt * 256, r0 = 2 * wave;
    bf16x8 qf[2][4]; f32x4 o[2][8]; float lsum[2] = {0.f, 0.f};
#pragma unroll
    for (int gi = 0; gi < 2; ++gi) {
#pragma unroll
        for (int ks = 0; ks < 4; ++ks) qf[gi][ks] = ld16(QN + (size_t)(t0 + 16 * li + r0 + gi) * 1024 + h * HD + 32 * ks + 8 * quad);
#pragma unroll
        for (int dt = 0; dt < 8; ++dt) o[gi][dt] = (f32x4){0.f, 0.f, 0.f, 0.f};
    }
    asm volatile("s_waitcnt vmcnt(0) lgkmcnt(0)" ::: "memory");
    __syncthreads();
    const int jmin = (16 - 2 * qt) > 0 ? (16 - 2 * qt) : 0;
    const int jn = jmin > 12 ? jmin : 12;
    if (jmin < 12) {
        LAS unsigned char* ring = lds + wave * FR_WAVE; const int ngc = 2 * (12 - jmin);
        far_stage(ring, 0, Kg, Vg, t0 - 2048 + 128 * jmin + r0, lane); far_stage(ring, 1, Kg, Vg, t0 - 2048 + 128 * jmin + r0 + 1, lane); far_stage(ring, 2, Kg, Vg, t0 - 2048 + 128 * (jmin + 1) + r0, lane);
#pragma unroll 1
        for (int gc = 0; gc < ngc; gc += 4) {
            far_step<0>(lds, ring, Kg, Vg, t0, jmin, r0, gc, ngc, lane, qf, o, lsum); far_step<1>(lds, ring, Kg, Vg, t0, jmin, r0, gc + 1, ngc, lane, qf, o, lsum);
            far_step<2>(lds, ring, Kg, Vg, t0, jmin, r0, gc + 2, ngc, lane, qf, o, lsum); far_step<3>(lds, ring, Kg, Vg, t0, jmin, r0, gc + 3, ngc, lane, qf, o, lsum);
        }
        asm volatile("s_waitcnt vmcnt(0) lgkmcnt(0)" ::: "memory");
        __builtin_amdgcn_s_barrier(); asm volatile("" ::: "memory");
    }
    attn2_stage(lds, 0, Kg, Vg, t0 - 2048 + 128 * jn, wave, lane);
    asm volatile("s_waitcnt vmcnt(0)" ::: "memory");
    __builtin_amdgcn_s_barrier(); asm volatile("" ::: "memory");
#pragma unroll 1
    for (int j = jn; j < 18; j += 2) {
        attn2_chunk<0>(lds, Kg, Vg, t0, j, r0, wave, lane, qf, o, lsum);
        attn2_chunk<1>(lds, Kg, Vg, t0, j + 1, r0, wave, lane, qf, o, lsum);
    }
#pragma unroll
    for (int gi = 0; gi < 2; ++gi) {
        float l = lsum[gi]; l += __shfl_xor(l, 16); l += __shfl_xor(l, 32);
        const float inv = 1.0f / l;
        bf16* orow = MIX + (size_t)(t0 + 16 * li + r0 + gi) * DM + DATT + h * HD + 4 * quad;
#pragma unroll
        for (int dt = 0; dt < 8; ++dt) { v2u w; w.x = pg8::cvt_pk_bf16(o[gi][dt][0] * inv, o[gi][dt][1] * inv); w.y = pg8::cvt_pk_bf16(o[gi][dt][2] * inv, o[gi][dt][3] * inv); *(GAS v2u*)(orow + 16 * dt) = w; }
    }
}
__device__ __forceinline__ void load_q_frags(bf16x8 (&qf)[4], const bf16* qrow, const float* gq, int quad, float scale = QSCALE) {
    float f[32];
#pragma unroll
    for (int ks = 0; ks < 4; ++ks) unpack8(*(const GAS v4u*)(qrow + 32 * ks + 8 * quad), f + 8 * ks);
    float ss = 0.f;
#pragma unroll
    for (int i = 0; i < 32; ++i) ss += f[i] * f[i];
    ss += __shfl_xor(ss, 16); ss += __shfl_xor(ss, 32);
    const float sc = scale / sqrtf(ss * (1.f / HD) + EPS);
#pragma unroll
    for (int ks = 0; ks < 4; ++ks) { const f32x4 g0 = *(const GAS f32x4*)(gq + 32 * ks + 8 * quad), g1 = *(const GAS f32x4*)(gq + 32 * ks + 8 * quad + 4); const float* e = f + 8 * ks;
        v4u w; w.x = pg8::cvt_pk_bf16(e[0] * sc * g0[0], e[1] * sc * g0[1]); w.y = pg8::cvt_pk_bf16(e[2] * sc * g0[2], e[3] * sc * g0[3]); w.z = pg8::cvt_pk_bf16(e[4] * sc * g1[0], e[5] * sc * g1[1]); w.w = pg8::cvt_pk_bf16(e[6] * sc * g1[2], e[7] * sc * g1[3]);
        qf[ks] = __builtin_bit_cast(bf16x8, w); }
}
constexpr int PL_KV = (WBUF + NSAMP) / 32, PL_CONV = MT / 16, PL_ITEMS = PL_KV + PL_CONV;
__device__ __forceinline__ void postlite_item(const Args& A, int item) {
    const int tid = opaque_tid(), lane = tid & 63, wave = __builtin_amdgcn_readfirstlane(tid >> 6);
    const bf16* PROJ = (const bf16*)(A.ws + WS_PROJ); bf16* MIX = (bf16*)(A.ws + WS_MIX);
    if (item < PL_KV) {
        v4u kw[4][2], vw[4][2];
#pragma unroll
        for (int q = 0; q < 4; ++q) { const int tk_ = (SEQ - WBUF) + item * 32 + wave * 4 + q; const bf16* prow = PROJ + (size_t)tk_ * DIN; const GAS v4u* pk = tk_ >= SEQ ? (const GAS v4u*)(prow + 4096 + lane * 16) : (const GAS v4u*)((const bf16*)(A.ws + WS_KN) + (size_t)tk_ * 1024 + lane * 16); const GAS v4u* pv = (const GAS v4u*)(prow + 5120 + lane * 16);
            kw[q][0] = pk[0]; kw[q][1] = pk[1]; vw[q][0] = pv[0]; vw[q][1] = pv[1]; }
        f32x4 g[4];
#pragma unroll
        for (int j = 0; j < 4; ++j) g[j] = *(const GAS f32x4*)(A.k_norm + (lane & 7) * 16 + 4 * j);
#pragma unroll
        for (int q = 0; q < 4; ++q) { const int tok = (SEQ - WBUF) + item * 32 + wave * 4 + q;
            float* ko; float* vo;
            if (tok >= SEQ) { ko = A.out + O_SK + (size_t)(tok - SEQ) * 1024; vo = A.out + O_SV + (size_t)(tok - SEQ) * 1024; }
            else { ko = A.out + O_PK + (size_t)(tok - (SEQ - WBUF)) * 1024; vo = A.out + O_PV + (size_t)(tok - (SEQ - WBUF)) * 1024; }
            float f[16]; unpack8(kw[q][0], f); unpack8(kw[q][1], f + 8);
            float ss = 0.f;
#pragma unroll
            for (int j = 0; j < 16; ++j) ss += f[j] * f[j];
            ss += __shfl_xor(ss, 1); ss += __shfl_xor(ss, 2); ss += __shfl_xor(ss, 4);
            const float rstd = 1.0f / sqrtf(ss * (1.f / HD) + EPS);
            GAS f32x4* o = (GAS f32x4*)(ko + lane * 16);
            if (tok >= SEQ) {
#pragma unroll
                for (int j = 0; j < 4; ++j) __builtin_nontemporal_store((f32x4){f[4 * j] * rstd * g[j][0], f[4 * j + 1] * rstd * g[j][1], f[4 * j + 2] * rstd * g[j][2], f[4 * j + 3] * rstd * g[j][3]}, o + j);
            } else {
#pragma unroll
                for (int j = 0; j < 4; ++j) __builtin_nontemporal_store((f32x4){f[4 * j], f[4 * j + 1], f[4 * j + 2], f[4 * j + 3]}, o + j); }
            unpack8(vw[q][0], f); unpack8(vw[q][1], f + 8);
            GAS f32x4* ov = (GAS f32x4*)(vo + lane * 16);
#pragma unroll
            for (int j = 0; j < 4; ++j) __builtin_nontemporal_store((f32x4){f[4 * j], f[4 * j + 1], f[4 * j + 2], f[4 * j + 3]}, ov + j); }
    } else {
        const int tb = (item - PL_KV) * 16;
#pragma unroll 2
        for (int it = tid; it < 16 * (DCONV / 8); it += NTHR) {
            const int tok = tb + (it >> 7), c8 = (it & 127) * 8;
            const bool samp = tok >= SEQ; const int b = (tok - SEQ) >> 3, i = samp ? ((tok - SEQ) & 7) : tok;
            v4u xw[3], cw[3]; f32x4 s0[2], s1[2];
#pragma unroll
            for (int k = 0; k < 3; ++k) { const int ii = i - 2 + k; const bf16* pr = PROJ + (size_t)(tok - 2 + k) * DIN;
                if (ii >= 0) { xw[k] = *(const GAS v4u*)(pr + c8); cw[k] = *(const GAS v4u*)(pr + 2048 + c8); } else { xw[k] = (v4u){0u, 0u, 0u, 0u}; cw[k] = (v4u){0u, 0u, 0u, 0u}; } }
            if (samp && i < 2) { const float* st = A.state_conv + ((size_t)b * 2) * DCONV + c8; s0[0] = *(const GAS f32x4*)(st); s0[1] = *(const GAS f32x4*)(st + 4); s1[0] = *(const GAS f32x4*)(st + DCONV); s1[1] = *(const GAS f32x4*)(st + DCONV + 4); }
            const v4u bw = *(const GAS v4u*)(PROJ + (size_t)tok * DIN + 1024 + c8);
            float u[3][8];
#pragma unroll
            for (int k = 0; k < 3; ++k) { float xc[8], cg[8]; unpack8(xw[k], xc); unpack8(cw[k], cg);
#pragma unroll
                for (int j = 0; j < 8; ++j) u[k][j] = cg[j] * xc[j]; }
            if (samp && i < 2) {
#pragma unroll
                for (int j = 0; j < 8; ++j) { const float st0 = j < 4 ? s0[0][j] : s0[1][j - 4], st1 = j < 4 ? s1[0][j] : s1[1][j - 4];
                    if (i == 0) { u[0][j] = st0; u[1][j] = st1; } else { u[0][j] = st1; } } }
            float bg[8]; unpack8(bw, bg);
            float y[8];
#pragma unroll
            for (int j = 0; j < 8; ++j) y[j] = bg[j] * (u[0][j] * A.conv_w[c8 + j] + u[1][j] * A.conv_w[DCONV + c8 + j] + u[2][j] * A.conv_w[2 * DCONV + c8 + j]);
            v4u w; w.x = pk2(y[0], y[1]); w.y = pk2(y[2], y[3]); w.z = pk2(y[4], y[5]); w.w = pk2(y[6], y[7]);
            *(GAS v4u*)(MIX + (size_t)tok * DM + c8) = w;
            float* co = nullptr;
            if (samp) { if (i >= 6) co = A.out + O_SC + ((size_t)b * 2 + (i - 6)) * DCONV + c8; }
            else if (tok >= SEQ - 2) co = A.out + O_PC + (size_t)(tok - (SEQ - 2)) * DCONV + c8;
            if (co) {
#pragma unroll
                for (int j = 0; j < 8; ++j) co[j] = u[2][j]; }
        }
    }
}
__device__ __forceinline__ int att_mult(int dist) { return (dist <= 128 ? 1 : 0) + (((dist & 3) == 0 && dist <= 512) ? 1 : 0) + (((dist & 15) == 0 && dist <= 2048) ? 1 : 0); }
constexpr int SROWS = 1288, S_TBL = 0, S_Q = 8256, S_P = S_Q + 4096, S_OP = S_P + SROWS * 32, S_LP = S_OP + 65536, S_KT = 122880, S_END = S_KT + 32768;
__device__ __forceinline__ void attn_sample_unit(const Args& A, LAS unsigned char* lds, int b, int h, float Mp) {
    const int tid = opaque_tid(), lane = tid & 63, wave = __builtin_amdgcn_readfirstlane(tid >> 6);
    const bf16* PROJ = (const bf16*)(A.ws + WS_PROJ); const bf16* QN = (const bf16*)(A.ws + WS_QN); const bf16* KN = (const bf16*)(A.ws + WS_KN); bf16* MIX = (bf16*)(A.ws + WS_MIX);
    LAS float* tblS = (LAS float*)(lds + S_TBL); LAS float* q_s = (LAS float*)(lds + S_Q); LAS float* P_T = (LAS float*)(lds + S_P); LAS float* Opart = (LAS float*)(lds + S_OP); LAS float* lpart = (LAS float*)(lds + S_LP);
    __syncthreads();
    {
        LAS float* rb = q_s; LAS unsigned* bkw = (LAS unsigned*)(q_s + 32);
        if (tid < 32) rb[tid] = A.rel_bias[tid * NH + h] * LOG2E - Mp;
        else if (tid < 32 + 99) bkw[tid - 32] = ((const unsigned*)&BUCKET[0][0])[tid - 32];
        __syncthreads();
        const LAS unsigned char* bkb = (const LAS unsigned char*)bkw;
        for (int x = tid; x < 2064; x += NTHR) { float v = -1e30f;
            if (x <= 2055) { const int c = att_mult(x); if (c > 0) { const int bk = x <= 128 ? bkb[x] : (((x & 3) == 0 && x <= 512) ? bkb[132 + (x >> 2)] : bkb[264 + (x >> 4)]);
                v = (c == 1 ? 0.f : (c == 2 ? 1.f : 1.5849625007211562f)) + rb[bk]; } }
            tblS[x] = v; }
    }
    __syncthreads();
    {
        const int li = lane & 15, quad = lane >> 4;
        bf16x8 qf[4];
#pragma unroll
        for (int ks = 0; ks < 4; ++ks) qf[ks] = (bf16x8){0, 0, 0, 0, 0, 0, 0, 0};
        load_q_frags(qf, PROJ + (size_t)(SEQ + b * 8 + (li & 7)) * DIN + 3072 + h * HD, A.q_norm, quad);
        const float* kbase = A.cache_k + ((size_t)b * WBUF * NH + h) * HD + 4 * (lane & 31);
        f32x4 ka[8], kb[8];
        const int half_ = lane >> 5, l32_ = lane & 31;
        LAS unsigned char* ktile = lds + S_KT + wave * 4096;
#define SC_LOAD(dst, ti) do { _Pragma("unroll") for (int x_ = 0; x_ < 8; ++x_) { const int n_ = 16 * (ti) + 2 * x_ + half_, p_ = n_ < 768 ? ((n_ >> 3) * 16 + (n_ & 7)) : n_ + 768; \
            dst[x_] = __builtin_nontemporal_load((const GAS f32x4*)(kbase + (size_t)p_ * (NH * HD))); } } while (0)
#define SC_TILE(src_, ti) do { f32x4 s_ = (f32x4){0.f, 0.f, 0.f, 0.f}; \
        _Pragma("unroll") for (int x_ = 0; x_ < 8; ++x_) { const int row_ = 2 * x_ + half_; v2u w_; w_.x = pg8::cvt_pk_bf16(src_[x_][0], src_[x_][1]); w_.y = pg8::cvt_pk_bf16(src_[x_][2], src_[x_][3]); \
            *(LAS v2u*)(ktile + row_ * 256 + 16 * ((l32_ >> 1) ^ row_) + 8 * (l32_ & 1)) = w_; }              \
        asm volatile("s_waitcnt lgkmcnt(0)" ::: "memory"); \
        _Pragma("unroll") for (int ks = 0; ks < 4; ++ks) { const bf16x8 kf_ = *(const LAS bf16x8*)(ktile + li * 256 + 16 * ((4 * ks + quad) ^ li)); \
            s_ = __builtin_amdgcn_mfma_f32_16x16x32_bf16(kf_, qf[ks], s_, 0, 0, 0); } \
        if (li < 8) { _Pragma("unroll") for (int rg = 0; rg < 4; ++rg) { const int n_ = 16 * (ti) + 4 * quad + rg, p_ = n_ < 768 ? ((n_ >> 3) * 16 + (n_ & 7)) : n_ + 768, dist_ = WBUF + li - p_; \
            P_T[n_ * 8 + li] = __builtin_amdgcn_exp2f(s_[rg] + tblS[dist_ < 0 ? 2056 : dist_]); } } } while (0)
        SC_LOAD(ka, wave);
#pragma unroll 1
        for (int k = 0; k < 8; k += 2) {
            SC_LOAD(kb, wave + NWAVES * (k + 1));
            SC_TILE(ka, wave + NWAVES * k);
            SC_LOAD(ka, wave + NWAVES * (k + 2));
            SC_TILE(kb, wave + NWAVES * (k + 1));
        }
        SC_LOAD(kb, wave + NWAVES * 9);
        SC_TILE(ka, wave + NWAVES * 8);
        SC_TILE(kb, wave + NWAVES * 9);
#undef SC_LOAD
#undef SC_TILE
        if (wave == 0) {
            f32x4 s_ = (f32x4){0.f, 0.f, 0.f, 0.f};
            bf16x8 kn[4]; load_q_frags(kn, PROJ + (size_t)(SEQ + b * 8 + (li & 7)) * DIN + 4096 + h * HD, A.k_norm, quad, 1.0f);
#pragma unroll
            for (int ks = 0; ks < 4; ++ks) s_ = __builtin_amdgcn_mfma_f32_16x16x32_bf16(kn[ks], qf[ks], s_, 0, 0, 0);
            if (li < 8 && quad < 2) {
#pragma unroll
                for (int rg = 0; rg < 4; ++rg) { const int rr = 4 * quad + rg, dist_ = li - rr; P_T[(SROWS - 8 + rr) * 8 + li] = __builtin_amdgcn_exp2f(s_[rg] + tblS[dist_ < 0 ? 2056 : dist_]); } }
        }
    }
    __syncthreads();
    {
        const int half = lane >> 5, l32 = lane & 31;
        f32x4 o[8]; float la[8];
#pragma unroll
        for (int i = 0; i < 8; ++i) { o[i] = (f32x4){0.f, 0.f, 0.f, 0.f}; la[i] = 0.f; }
        const float* vbase = A.cache_v + ((size_t)b * WBUF * NH + h) * HD + 4 * l32;
        f32x4 va[8], vb[8];
#define PV_LOAD(dst, k0) do { _Pragma("unroll") for (int u = 0; u < 8; ++u) { const int n_ = 2 * (wave + NWAVES * ((k0) + u)) + half, p_ = n_ < 768 ? ((n_ >> 3) * 16 + (n_ & 7)) : n_ + 768; dst[u] = __builtin_nontemporal_load((const GAS f32x4*)(vbase + (size_t)p_ * (NH * HD))); } } while (0)
#define PV_ACC(src_, k0) do { _Pragma("unroll") for (int u = 0; u < 8; ++u) { const int n_ = 2 * (wave + NWAVES * ((k0) + u)) + half; \
            const f32x4 pa = *(const LAS f32x4*)(P_T + n_ * 8), pb = *(const LAS f32x4*)(P_T + n_ * 8 + 4); \
            _Pragma("unroll") for (int i = 0; i < 4; ++i) { o[i] += src_[u] * pa[i]; la[i] += pa[i]; o[4 + i] += src_[u] * pb[i]; la[4 + i] += pb[i]; } } } while (0)
        PV_LOAD(va, 0);
#pragma unroll 1
        for (int k0 = 0; k0 < 64; k0 += 16) {
            PV_LOAD(vb, k0 + 8);
            PV_ACC(va, k0);
            PV_LOAD(va, k0 + 16);
            PV_ACC(vb, k0 + 8);
        }
        PV_LOAD(vb, 72);
        PV_ACC(va, 64);
        PV_ACC(vb, 72);
#undef PV_LOAD
#undef PV_ACC
        if (wave < 4) {
            const int n = SROWS - 8 + 2 * wave + half; const v2u w = *(const GAS v2u*)(PROJ + (size_t)(SEQ + b * 8 + (n - (SROWS - 8))) * DIN + 5120 + h * HD + 4 * l32);
            const f32x4 vv = (f32x4){bf_lo(w.x), bf_hi(w.x), bf_lo(w.y), bf_hi(w.y)};
            const f32x4 pa = *(const LAS f32x4*)(P_T + n * 8), pb = *(const LAS f32x4*)(P_T + n * 8 + 4);
#pragma unroll
            for (int i = 0; i < 4; ++i) { o[i] += vv * pa[i]; la[i] += pa[i]; o[4 + i] += vv * pb[i]; la[4 + i] += pb[i]; }
        }
        const int hw = wave * 2 + half;
#pragma unroll
        for (int i = 0; i < 8; ++i) { *(LAS f32x4*)(Opart + (hw * 8 + i) * 128 + 4 * l32) = o[i]; if (l32 == 0) lpart[hw * 8 + i] = la[i]; }
    }
    __syncthreads();
    {   const int i = tid >> 6, d = 2 * (tid & 63); float a0 = 0.f, a1 = 0.f, l = 0.f;
#pragma unroll
        for (int w = 0; w < 2 * NWAVES; ++w) { const f32x2 v = *(const LAS f32x2*)(Opart + (w * 8 + i) * 128 + d); a0 += v.x; a1 += v.y; l += lpart[w * 8 + i]; }
        const float inv = 1.0f / l;
        *(GAS unsigned*)(MIX + (size_t)(SEQ + b * 8 + i) * DM + DATT + h * HD + d) = pk2(a0 * inv, a1 * inv);
    }
}
__device__ __forceinline__ void phase_attn(const Args& A, LAS unsigned char* lds, int vcu, int G) {
    const float Mp = softmax_bound_l2(A, threadIdx.x & 63);
    for (int pass = 0; pass < 2; ++pass) {
        const bool prompt = ((vcu & 1) == 0) == (pass == 0);
#ifndef REP_PR
#define REP_PR 1
#endif
#ifndef REP_SA
#define REP_SA 1
#endif
        if (prompt) { for (int rep = 0; rep < REP_PR; ++rep) for (int u = vcu; u < NH * (SEQ / 256); u += G) attn2_prompt_unit(A, lds, u >> 5, u & 31, Mp); }
        else { for (int rep = 0; rep < REP_SA; ++rep) for (int u = vcu; u < DBATCH * NH; u += G) attn_sample_unit(A, lds, u >> 3, u & 7, Mp); }
    }
    volatile LAS int* qslot = (volatile LAS int*)(lds + LDS_ST_OFF + 16);
    for (;;) {
        __syncthreads();
        if (threadIdx.x == 0) *qslot = (int)__hip_atomic_fetch_add((unsigned*)(A.ws + WS_CTL), 1u, __ATOMIC_RELAXED, __HIP_MEMORY_SCOPE_AGENT);
        __syncthreads();
        const int item = *qslot;
        if (item >= PL_ITEMS + PL_GU) break;
        if (item < PL_ITEMS) postlite_item(A, item); else convert_gu_item(A, lds, item - PL_ITEMS);
    }
}

template <int N> __device__ __forceinline__ void wait_vm() { asm volatile("s_waitcnt vmcnt(%0)" :: "n"(N) : "memory"); }
template <int MB, int NB, int KC, int NSLOT, int NCH, class Epi>
__device__ __forceinline__ void skinny2(const bf16* A, const bf16* Bt, int tile, LAS unsigned char* lds, const Epi& E) {
    constexpr int K = KC * NCH, RT = 256 / (16 * MB), W = 16 * NB, R = 16 * (MB + NB), ROWB = KC * 2, CHB = R * ROWB, LPR = ROWB / 16, RPI = 64 / LPR, NI = R / RPI, NL = NI / 8, NJ = MB * NB / 8, KS = KC / 32;
    static_assert(NI % 8 == 0 && NSLOT * CHB <= 131072 && (MB * NB) % 8 == 0 && 8 % MB == 0 && LPR >= 16 && NSLOT >= 3, "skinny2 shape");
    const int tid = opaque_tid(), lane = tid & 63, wave = __builtin_amdgcn_readfirstlane(tid >> 6), fr = lane & 15, fq = lane >> 4;
    const int rt = tile % RT, ct = tile / RT;
    const bf16* gp[NL];
#pragma unroll
    for (int i = 0; i < NL; ++i) { const int q = wave + 8 * i, row = q * RPI + lane / LPR, piece = (lane % LPR) ^ (row & 15);
        const bf16* rp = row < 16 * MB ? A + (size_t)(16 * MB * rt + row) * K : Bt + (size_t)(W * ct + row - 16 * MB) * K; gp[i] = rp + 8 * piece; }
    const int mi = wave % MB, g = wave / MB;
    f32x4 acc[NJ];
#pragma unroll
    for (int j = 0; j < NJ; ++j) acc[j] = (f32x4){0.f, 0.f, 0.f, 0.f};
    const unsigned aoff = (unsigned)(16 * mi + fr) * ROWB, boff = (unsigned)(16 * MB + 16 * NJ * g + fr) * ROWB;
#define SK2_STAGE(c) do { _Pragma("unroll") for (int i_ = 0; i_ < NL; ++i_) __builtin_amdgcn_global_load_lds((const unsigned*)(gp[i_] + (size_t)(c) * KC), (LAS unsigned*)(lds + ((c) % NSLOT) * CHB + (wave + 8 * i_) * 1024), 16, 0, 0); } while (0)
#pragma unroll
    for (int c = 0; c < NSLOT - 1; ++c) if (c < NCH) SK2_STAGE(c);
#pragma unroll
    for (int c = 0; c < NCH; ++c) {
        const int ahead = (NCH - 1 - c) < (NSLOT - 2) ? (NCH - 1 - c) : (NSLOT - 2);
        if (ahead >= 2) wait_vm<2 * NL>(); else if (ahead == 1) wait_vm<NL>(); else wait_vm<0>();
        __builtin_amdgcn_s_barrier(); asm volatile("" ::: "memory");
        if (c + NSLOT - 1 < NCH) SK2_STAGE(c + NSLOT - 1);
        const LAS unsigned char* sb = lds + (c % NSLOT) * CHB;
#pragma unroll
        for (int kk = 0; kk < KS; ++kk) { const unsigned po = 16u * (unsigned)((4 * kk + fq) ^ fr);
            const bf16x8 af = *(const LAS bf16x8*)(sb + aoff + po);
#pragma unroll
            for (int j = 0; j < NJ; ++j) { const bf16x8 bf = *(const LAS bf16x8*)(sb + boff + j * 16 * ROWB + po); acc[j] = __builtin_amdgcn_mfma_f32_16x16x32_bf16(bf, af, acc[j], 0, 0, 0); } }
    }
#undef SK2_STAGE
    asm volatile("s_waitcnt lgkmcnt(0)" ::: "memory");
    __syncthreads();
#pragma unroll
    for (int j = 0; j < NJ; ++j) *(LAS f32x4*)(lds + ((16 * mi + fr) * W + 16 * (NJ * g + j) + 4 * fq) * 4) = acc[j];
    __syncthreads();
    constexpr int NCHK = 16 * MB * W / 4;
#pragma unroll
    for (int i = 0; i < NCHK / NTHR; ++i) { const int ch = tid + NTHR * i, row = ch / (W / 4), c4 = ch % (W / 4);
        const f32x4 v = *(const LAS f32x4*)(lds + (row * W + 4 * c4) * 4);
        E(16 * MB * rt + row, W * ct + 4 * c4, ct, v); }
    __syncthreads();
}
struct SkProj { bf16* PROJ; __device__ __forceinline__ void operator()(int row, int col, int, f32x4 v) const { v2u w; w.x = pg8::cvt_pk_bf16(v[0], v[1]); w.y = pg8::cvt_pk_bf16(v[2], v[3]); *(GAS v2u*)(PROJ + (size_t)(SEQ + row) * DIN + col) = w; } };
struct SkRes1 { const float* xs; bf16* X1b; float* SSQ;
    __device__ __forceinline__ void operator()(int row, int col, int ct, f32x4 v) const {
        const f32x4 o = *(const GAS f32x4*)(xs + (size_t)row * DM + col) + v; const size_t off = (size_t)(SEQ + row) * DM + col;
        v2u pk; pk.x = pg8::cvt_pk_bf16(o[0], o[1]); pk.y = pg8::cvt_pk_bf16(o[2], o[3]); *(GAS v2u*)(X1b + off) = pk;
        float ss = (o[0] * o[0] + o[1] * o[1]) + (o[2] * o[2] + o[3] * o[3]); ss += __shfl_xor(ss, 1); ss += __shfl_xor(ss, 2); ss += __shfl_xor(ss, 4); ss += __shfl_xor(ss, 8);
        if ((threadIdx.x & 15) == 0) SSQ[(size_t)(SEQ + row) * 32 + ct] = ss; } };
struct SkOut { const bf16* X1b; float* out; __device__ __forceinline__ void operator()(int row, int col, int, f32x4 v) const { const size_t off = (size_t)(SEQ + row) * DM + col; const v2u w = *(const GAS v2u*)(X1b + off);
        *(GAS f32x4*)(out + off) = (f32x4){bf_lo(w.x), bf_hi(w.x), bf_lo(w.y), bf_hi(w.y)} + v; } };

#define XB_TMO      128
#define XB_XCNT(j)  (256  + 64 * (j))
#define XB_XSUB(j)  (1280 + 64 * (j))
#define XB_XGEN(j)  (2304 + 64 * (j))
#define XB_TOP      3328
#define XB_TOPGEN   3392
#define XCD_BAR_WORDS 3456
#define XB_SPIN_CAP (1u << 18)
__device__ __forceinline__ unsigned xb_ld(unsigned* p)              { return __hip_atomic_load(p, __ATOMIC_RELAXED, __HIP_MEMORY_SCOPE_AGENT); }
__device__ __forceinline__ unsigned xb_add(unsigned* p, unsigned v) { return __hip_atomic_fetch_add(p, v, __ATOMIC_RELAXED, __HIP_MEMORY_SCOPE_AGENT); }
__device__ __forceinline__ unsigned xb_xcc_id() { return (unsigned)__builtin_amdgcn_s_getreg((3 << 11) | 20) & 0xFu; }
#define XB_SPIN(cond, bar) do { unsigned _sp = 0; while (cond) { __builtin_amdgcn_s_sleep(1); \
    if ((++_sp & 255u) == 0u) { if (xb_ld(&(bar)[XB_TMO])) break; if (_sp > XB_SPIN_CAP) { atomicAdd(&(bar)[XB_TMO], 1u); break; } } } } while (0)
struct XcdBarrier { unsigned* bar; unsigned x; volatile LAS unsigned* st; };
__device__ __forceinline__ XcdBarrier xcd_barrier_post(unsigned* bar, volatile LAS unsigned* st) {
    XcdBarrier b; b.bar = bar; b.x = xb_xcc_id(); b.st = st;
    if (threadIdx.x == 0) (void)xb_add(&bar[XB_XCNT(b.x)], 1u);
    return b;
}
__device__ __forceinline__ void xcd_barrier_complete(unsigned* bar, unsigned x, unsigned& nloc, unsigned& nx) {
    const unsigned G = gridDim.x * gridDim.y * gridDim.z;
    unsigned sum, cnt, mine, sp = 0u;
    for (;;) {
        sum = 0u; cnt = 0u; mine = 0u;
#pragma unroll
        for (unsigned j = 0; j < 16; ++j) { const unsigned c = xb_ld(&bar[XB_XCNT(j)]); sum += c; cnt += (c > 0u) ? 1u : 0u; mine = (j == x) ? c : mine; }
        if (sum == G) break;
        __builtin_amdgcn_s_sleep(1);
        if ((++sp & 255u) == 0u) { if (xb_ld(&bar[XB_TMO])) break; if (sp > XB_SPIN_CAP) { atomicAdd(&bar[XB_TMO], 1u); break; } }
    }
    nloc = mine > 0u ? mine : 1u; nx = cnt > 0u ? cnt : 1u;
}
__device__ __forceinline__ void xcd_barrier(const XcdBarrier& b) {
    asm volatile("s_waitcnt vmcnt(0)" ::: "memory");
    __syncthreads();
    if (threadIdx.x == 0) {
        unsigned* bar = b.bar;
        __builtin_amdgcn_s_waitcnt(0);
        unsigned nloc = b.st[0], nx = b.st[1];
        if (nloc == 0u) { xcd_barrier_complete(bar, b.x, nloc, nx); b.st[0] = nloc; b.st[1] = nx; }
        const unsigned old = xb_add(&bar[XB_XSUB(b.x)], 1u);
        const unsigned gen = old / nloc;
        if (old + 1u == (gen + 1u) * nloc) {
            __builtin_amdgcn_fence(__ATOMIC_RELEASE, "agent");
            asm volatile("s_waitcnt vmcnt(0)" ::: "memory");
            const unsigned og = xb_add(&bar[XB_TOP], 1u);
            const unsigned tg = og / nx;
            if (og + 1u == (tg + 1u) * nx) xb_add(&bar[XB_TOPGEN], 1u);
            else XB_SPIN(xb_ld(&bar[XB_TOPGEN]) == tg, bar);
            __builtin_amdgcn_fence(__ATOMIC_ACQUIRE, "agent");
            xb_add(&bar[XB_XGEN(b.x)], 1u);
            asm volatile("s_waitcnt vmcnt(0)" ::: "memory");
        } else {
            XB_SPIN(xb_ld(&bar[XB_XGEN(b.x)]) == gen, bar);
            __builtin_amdgcn_fence(__ATOMIC_ACQUIRE, "agent");
            asm volatile("s_waitcnt vmcnt(0)" ::: "memory");
        }
    }
    __syncthreads();
}
constexpr int CW_BAR = 4096;
constexpr size_t CTL_ZERO_BYTES = 65536;

namespace cg = cooperative_groups;
__device__ __forceinline__ int vcu_of(int bx, int G) { return (G % 8 == 0) ? (bx % 8) * (G / 8) + bx / 8 : bx; }
__global__ void __launch_bounds__(NTHR, 2) fwd_mega(Args A) {
    extern __shared__ __attribute__((aligned(16))) unsigned char lds_raw[];
    LAS unsigned char* lds = (LAS unsigned char*)lds_raw;
    const int G = gridDim.x, bx = blockIdx.x, vcu = vcu_of(bx, G);
    volatile LAS unsigned* st = (volatile LAS unsigned*)(lds + LDS_ST_OFF);
    if (threadIdx.x < 2) st[threadIdx.x] = 0u;
    __syncthreads();
    const XcdBarrier bar = xcd_barrier_post((unsigned*)(A.ws + WS_CTL) + CW_BAR, st);
#if defined(MK_CG_SYNC)
    cg::grid_group grid = cg::this_grid();
#define SEAM() grid.sync()
#else
#define SEAM() xcd_barrier(bar)
#endif
#ifndef REP_G1
#define REP_G1 1
#endif
#ifndef REP_G1S
#define REP_G1S 1
#endif
#ifndef REP_G2
#define REP_G2 1
#endif
#ifndef REP_G2S
#define REP_G2S 1
#endif
#ifndef REP_G3
#define REP_G3 1
#endif
#ifndef REP_G4
#define REP_G4 1
#endif
#ifndef REP_G4S
#define REP_G4S 1
#endif
#ifndef REP_P0
#define REP_P0 1
#endif
#ifndef REP_P2
#define REP_P2 1
#endif
#ifndef REP_P3
#define REP_P3 1
#endif
    for (int rep = 0; rep < REP_P0; ++rep) phase_prologue(A, lds, vcu, G);
    SEAM();
#pragma unroll 1
    for (int pass_ = 0; pass_ < 2; ++pass_) { if ((pass_ == 0) == ((vcu & 1) == 0)) {
for (int rep_ = 0; rep_ < REP_G1; ++rep_) { pg8::Gemm g{(const bf16*)(A.ws + WS_XN), (const bf16*)(A.ws + WS_WIN), SEQ, DIN, DM}; pg8::StaticOrder S; S.init(SEQ, DIN, G, bx);
      pg8::EpiProj E{(bf16*)(A.ws + WS_PROJ), DIN, (bf16*)(A.ws + WS_QN), (bf16*)(A.ws + WS_KN), A.q_norm, A.k_norm, A.out + O_PK, A.out + O_PV, (LAS float*)(lds + 135168)}; pg8::gemm_phase<pg8::EpiProj, pg8::StaticOrder, true, true>(lds, g, S, E); }
    } else {
for (int rep_ = 0; rep_ < REP_G1S; ++rep_) for (int t = vcu; t < 256; t += G) skinny2<4, 6, 128, 3, DM / 128>((const bf16*)(A.ws + WS_XN) + (size_t)SEQ * DM, (const bf16*)(A.ws + WS_WIN), t, lds, SkProj{(bf16*)(A.ws + WS_PROJ)});
    } }
    SEAM();
    for (int rep = 0; rep < REP_P3; ++rep) phase_attn(A, lds, vcu, G);
    SEAM();
#pragma unroll 1
    for (int pass_ = 0; pass_ < 2; ++pass_) { if ((pass_ == 0) == ((vcu & 1) == 0)) {
for (int rep_ = 0; rep_ < REP_G2; ++rep_) { pg8::Gemm g{(const bf16*)(A.ws + WS_MIX), (const bf16*)(A.ws + WS_WOUT), SEQ, DM, DM}; pg8::StaticOrder S; S.init(SEQ, DM, G, bx);
      pg8::EpiRes1 E{A.x_prompt, (bf16*)(A.ws + WS_XN2), (float*)(A.ws + WS_SSQ)}; pg8::gemm_phase<pg8::EpiRes1, pg8::StaticOrder, true, true>(lds, g, S, E); }
    } else {
for (int rep_ = 0; rep_ < REP_G2S; ++rep_) for (int t = vcu; t < 256; t += G) skinny2<2, 4, 128, 4, DM / 128>((const bf16*)(A.ws + WS_MIX) + (size_t)SEQ * DM, (const bf16*)(A.ws + WS_WOUT), t, lds, SkRes1{A.x_sample, (bf16*)(A.ws + WS_XN2), (float*)(A.ws + WS_SSQ)});
    } }
    SEAM();
for (int rep_ = 0; rep_ < REP_G3; ++rep_) { pg8::Gemm g{(const bf16*)(A.ws + WS_XN2), (const bf16*)(A.ws + WS_WGU), MT, NGU, DM}; pg8::StaticOrder S; S.init(MT, NGU, G, bx);
      pg8::EpiSwiGLU E{(const float*)(A.ws + WS_SSQ), (bf16*)(A.ws + WS_H)}; pg8::gemm_phase<pg8::EpiSwiGLU, pg8::StaticOrder, true, true>(lds, g, S, E); }
    { constexpr int NU3 = (MT / 256) * (NGU / 256); const int full = NU3 % G;
      if (full != 0 && bx >= full) convert_wdown(A, lds, bx - full, G - full); else if (full == 0) convert_wdown(A, lds, bx, G); }
    SEAM();
#pragma unroll 1
    for (int pass_ = 0; pass_ < 2; ++pass_) { if ((pass_ == 0) == ((vcu & 1) == 0)) {
for (int rep_ = 0; rep_ < REP_G4; ++rep_) { pg8::Gemm g{(const bf16*)(A.ws + WS_H), (const bf16*)(A.ws + WS_WDN), SEQ, DM, DFF}; pg8::StaticOrder S; S.init(SEQ, DM, G, bx);
      pg8::EpiOut E{(const bf16*)(A.ws + WS_XN2), A.out + O_Y}; pg8::gemm_phase<pg8::EpiOut, pg8::StaticOrder, true, true>(lds, g, S, E); }
    } else {
for (int rep_ = 0; rep_ < REP_G4S; ++rep_) for (int t = vcu; t < 256; t += G) skinny2<2, 4, 128, 4, DFF / 128>((const bf16*)(A.ws + WS_H) + (size_t)SEQ * DFF, (const bf16*)(A.ws + WS_WDN), t, lds, SkOut{(const bf16*)(A.ws + WS_XN2), A.out + O_Y});
    } }
}

extern "C" void kernel_launch(void* const* d_in, const int* in_sizes, int n_in, void* d_out, int out_size, void* d_ws, size_t ws_size, hipStream_t stream) {
    static int grid = 0;
    if (grid == 0) {
        if (n_in != 16 || (size_t)out_size != O_END || ws_size < WS_END) { fprintf(stderr, "kernel_launch: unexpected shapes: n_in %d out %d ws %zu\n", n_in, out_size, ws_size); grid = -1; return; }
        int dev = 0, cus = 0, per_cu = 0;
        if (hipGetDevice(&dev) != hipSuccess || hipDeviceGetAttribute(&cus, hipDeviceAttributeMultiprocessorCount, dev) != hipSuccess) { grid = -1; return; }
        if (hipFuncSetAttribute((const void*)fwd_mega, hipFuncAttributeMaxDynamicSharedMemorySize, LDS_BYTES) != hipSuccess) { fprintf(stderr, "kernel_launch: hipFuncSetAttribute failed\n"); grid = -1; return; }
        if (hipOccupancyMaxActiveBlocksPerMultiprocessor(&per_cu, (const void*)fwd_mega, NTHR, LDS_BYTES) != hipSuccess || per_cu < 1) { fprintf(stderr, "kernel_launch: occupancy query failed (%d)\n", per_cu); (void)hipGetLastError(); per_cu = 1; }
        if (per_cu > 1) per_cu = 1;
        grid = cus * per_cu;
    }
    if (grid < 0) return;
    Args a{};
    a.x_prompt = (const float*)d_in[0]; a.x_sample = (const float*)d_in[1]; a.cache_k = (const float*)d_in[2]; a.cache_v = (const float*)d_in[3]; a.state_conv = (const float*)d_in[4]; a.norm_mix = (const float*)d_in[5];
    a.w_in = (const float*)d_in[6]; a.conv_w = (const float*)d_in[7]; a.q_norm = (const float*)d_in[8]; a.k_norm = (const float*)d_in[9]; a.rel_bias = (const float*)d_in[10]; a.w_out = (const float*)d_in[11];
    a.norm_ffn = (const float*)d_in[12]; a.w_gate = (const float*)d_in[13]; a.w_up = (const float*)d_in[14]; a.w_down = (const float*)d_in[15];
    a.out = (float*)d_out; a.ws = (unsigned char*)d_ws;
    if (hipMemsetAsync((char*)d_ws + WS_CTL, 0, CTL_ZERO_BYTES, stream) != hipSuccess) { fprintf(stderr, "kernel_launch: memset of the control words failed\n"); return; }
    void* args[] = {&a};
    hipError_t e = hipLaunchCooperativeKernel((const void*)fwd_mega, dim3(grid), dim3(NTHR), args, LDS_BYTES, stream);
    if (e != hipSuccess) fprintf(stderr, "kernel_launch: cooperative launch failed: %s (grid %d)\n", hipGetErrorString(e), grid);
}
```

```cpp
#include <hip/hip_runtime.h>
#include <hip/hip_cooperative_groups.h>
#include <cstdio>
#include <cstdint>

constexpr int DM = 2048, SEQ = 8192, DBATCH = 32, DSEQ = 8, NSAMP = DBATCH * DSEQ, MT = SEQ + NSAMP;
constexpr int HD = 128, NH = 8, DATT = 1024, DCONV = 1024, DFF = 5632, DIN = 6144, WBUF = 2048, NGU = 2 * DFF;
constexpr float EPS = 1e-6f;
constexpr float LOG2E = 1.4426950408889634f;
constexpr float QSCALE = 0.08838834764831845f * LOG2E;

__device__ const unsigned char BUCKET[3][132] __attribute__((aligned(16))) = {
{0,1,2,3,4,5,6,7,8,9,10,11,12,13,14,15,16,16,16,16,16,16,17,17,17,17,17,17,17,17,18,18,18,18,18,18,18,18,18,18,19,19,19,19,19,19,19,19,19,19,19,19,19,19,20,20,20,20,20,20,20,20,20,20,20,20,20,20,20,20,20,20,20,21,21,21,21,21,21,21,21,21,21,21,21,21,21,21,21,21,21,21,21,21,21,21,21,21,21,22,22,22,22,22,22,22,22,22,22,22,22,22,22,22,22,22,22,22,22,22,22,22,22,22,22,22,22,22,22,0,0,0},
{0,4,8,12,16,16,17,17,18,18,19,19,19,19,20,20,20,20,20,21,21,21,21,21,21,22,22,22,22,22,22,22,22,22,23,23,23,23,23,23,23,23,23,23,23,23,24,24,24,24,24,24,24,24,24,24,24,24,24,24,24,24,25,25,25,25,25,25,25,25,25,25,25,25,25,25,25,25,25,25,25,25,25,26,26,26,26,26,26,26,26,26,26,26,26,26,26,26,26,26,26,26,26,26,26,26,26,26,26,26,26,26,26,27,27,27,27,27,27,27,27,27,27,27,27,27,27,27,27,0,0,0},
{0,16,18,19,20,21,21,22,22,23,23,23,24,24,24,24,25,25,25,25,25,26,26,26,26,26,26,26,26,27,27,27,27,27,27,27,27,27,27,28,28,28,28,28,28,28,28,28,28,28,28,28,29,29,29,29,29,29,29,29,29,29,29,29,29,29,29,29,29,29,30,30,30,30,30,30,30,30,30,30,30,30,30,30,30,30,30,30,30,30,30,30,30,30,30,31,31,31,31,31,31,31,31,31,31,31,31,31,31,31,31,31,31,31,31,31,31,31,31,31,31,31,31,31,31,31,31,31,31,0,0,0}};

#ifndef REP_E1
#define REP_E1 1
#endif
#ifndef REP_E2
#define REP_E2 1
#endif
#ifndef REP_E3
#define REP_E3 1
#endif
#ifndef REP_E4
#define REP_E4 1
#endif
#ifndef PG8_ROWMAJOR
#define PG8_ROWMAJOR 1
#endif
namespace pg8 {
#define PG8_LAS __attribute__((address_space(3)))
typedef unsigned short bf16_t;
typedef short bf16x8 __attribute__((ext_vector_type(8)));
typedef float f32x4 __attribute__((ext_vector_type(4)));
typedef unsigned u32x4 __attribute__((ext_vector_type(4)));
typedef unsigned u32x2 __attribute__((ext_vector_type(2)));
constexpr int BM = 256, BK = 64, HALF = 128, HTB = HALF * BK * 2  , STAGE_BYTES = 8 * HTB, NXCD = 8, WGM = 8;

__host__ __device__ __forceinline__ int lds_byte(int r, int c) { const int st = (r >> 4) * 2 + (c >> 5), rr = r & 15, cc = c & 31, ob = rr * 64 + cc * 2; return st * 1024 + (ob ^ (((ob >> 9) & 1) << 5)); }
__host__ __device__ __forceinline__ void stage_rc(int b, int& R, int& C) { const int st = b / 1024, sb = b % 1024, swz = sb ^ (((sb >> 9) & 1) << 5); R = (st >> 1) * 16 + swz / 64; C = (st & 1) * 32 + (swz % 64) / 2; }
__host__ __device__ __forceinline__ int perm32(int rho) { const int n = rho >> 4, i = rho & 15; return 8 * (i >> 2) + 4 * n + (i & 3); }

struct Unit { int pm, pn; };
struct Gemm { const bf16_t* A; const bf16_t* Bt; int M, N, K; };

struct StaticOrder {
    int nM, nN, nwg, G, c;
    __host__ __device__ void init(int M, int N, int G_, int c_) { nM = M / BM; nN = N / BM; nwg = nM * nN; G = G_; c = c_; }
    __host__ __device__ bool next(int i, Unit& u) const {
        const long L = (long)i * G + c; if (L >= nwg) return false;
        int wgid = (int)L; { const int q = nwg / NXCD, r = nwg % NXCD, xcd = wgid % NXCD, off = wgid / NXCD; wgid = (xcd < r ? xcd * (q + 1) : r * (q + 1) + (xcd - r) * q) + off; }
        const int nig = WGM * nN, gid = wgid / nig, fm = gid * WGM, gsz = (nM - fm) < WGM ? (nM - fm) : WGM;
        u.pm = fm + ((wgid % nig) % gsz); u.pn = (wgid % nig) / gsz; return true;
    }
    __device__ __forceinline__ void a_ready(const Unit&) const {}
    __device__ __forceinline__ void done(const Unit&) const {}
};

__device__ __forceinline__ unsigned cvt_pk_bf16(float lo, float hi) { unsigned r; asm volatile("v_cvt_pk_bf16_f32 %0, %1, %2" : "=v"(r) : "v"(lo), "v"(hi)); return r; }

struct EpiProj {
    static constexpr int REPS = REP_E1; static constexpr bool PERM = true, AFTER_DRAIN = false;
    bf16_t* O; int ldc; bf16_t* QN; bf16_t* KN; const float* gq; const float* gk; float* out_k; float* out_v; PG8_LAS float* xch;
    __device__ __forceinline__ void operator()(const f32x4 (&acc)[2][2][4][2], const Unit& u, int wr, int wc, int fr, int fq) const {
        const int row0 = u.pm * BM + wr * 64 + fr, col0 = u.pn * BM + wc * 32 + 8 * fq;
        const bool isq = u.pn >= 12 && u.pn < 16, isk = u.pn >= 16 && u.pn < 20, isv = u.pn >= 20;
        if (isq || isk) {
#pragma unroll
            for (int ai = 0; ai < 2; ++ai)
#pragma unroll
                for (int m = 0; m < 4; ++m)
#pragma unroll
                    for (int bj = 0; bj < 2; ++bj) { const f32x4 v0 = acc[ai][bj][m][0], v1 = acc[ai][bj][m][1];
                        float ss = ((v0[0] * v0[0] + v0[1] * v0[1]) + (v0[2] * v0[2] + v0[3] * v0[3])) + ((v1[0] * v1[0] + v1[1] * v1[1]) + (v1[2] * v1[2] + v1[3] * v1[3]));
                        ss += __shfl_xor(ss, 16); ss += __shfl_xor(ss, 32);
                        if (fq == 0) xch[((ai * HALF + wr * 64 + m * 16 + fr) * 2 + bj) * 4 + wc] = ss; }
        }
        asm volatile("s_waitcnt lgkmcnt(0)" ::: "memory"); __builtin_amdgcn_s_barrier(); asm volatile("" ::: "memory");
        if (isq || isk) {
            const float* g = isq ? gq : gk; const float gs = isq ? QSCALE : 1.0f; bf16_t* dst = isq ? QN : KN; const int hc0 = (u.pn - (isq ? 12 : 16)) * BM;
            f32x4 g0[2], g1[2];
#pragma unroll
            for (int bj = 0; bj < 2; ++bj) { g0[bj] = *(const f32x4*)(g + wc * 32 + 8 * fq) * gs; g1[bj] = *(const f32x4*)(g + wc * 32 + 8 * fq + 4) * gs; }
#pragma unroll
            for (int ai = 0; ai < 2; ++ai)
#pragma unroll
                for (int m = 0; m < 4; ++m) { const int r = row0 + ai * HALF + m * 16;
#pragma unroll
                    for (int bj = 0; bj < 2; ++bj) { const f32x4 p = *(const PG8_LAS f32x4*)(xch + ((ai * HALF + wr * 64 + m * 16 + fr) * 2 + bj) * 4);
                        const float rstd = 1.0f / sqrtf(((p[0] + p[1]) + (p[2] + p[3])) * (1.0f / 128.0f) + EPS);
                        const f32x4 v0 = acc[ai][bj][m][0] * rstd * g0[bj], v1 = acc[ai][bj][m][1] * rstd * g1[bj];
                        u32x4 w; w.x = cvt_pk_bf16(v0[0], v0[1]); w.y = cvt_pk_bf16(v0[2], v0[3]); w.z = cvt_pk_bf16(v1[0], v1[1]); w.w = cvt_pk_bf16(v1[2], v1[3]);
                        *(u32x4*)(dst + (size_t)r * 1024 + hc0 + bj * HALF + wc * 32 + 8 * fq) = w;
} }
        } else {
#pragma unroll
            for (int ai = 0; ai < 2; ++ai)
#pragma unroll
                for (int m = 0; m < 4; ++m) { const int r = row0 + ai * HALF + m * 16; bf16_t* rowp = O + (size_t)r * ldc + col0;
#pragma unroll
                    for (int bj = 0; bj < 2; ++bj) { const f32x4 v0 = acc[ai][bj][m][0], v1 = acc[ai][bj][m][1];
                        u32x4 w; w.x = cvt_pk_bf16(v0[0], v0[1]); w.y = cvt_pk_bf16(v0[2], v0[3]); w.z = cvt_pk_bf16(v1[0], v1[1]); w.w = cvt_pk_bf16(v1[2], v1[3]);
                        *(u32x4*)(rowp + bj * HALF) = w;
} }
        }
    }
};
struct EpiRes1 {
    static constexpr int REPS = REP_E2; static constexpr bool PERM = false, AFTER_DRAIN = false;
    const float* xp; bf16_t* X1b; float* SSQ;
    __device__ __forceinline__ void operator()(const f32x4 (&acc)[2][2][4][2], const Unit& u, int wr, int wc, int fr, int fq) const {
        const int row0 = u.pm * BM + wr * 64 + fr, col0 = u.pn * BM + wc * 32 + 4 * fq;
#pragma unroll
        for (int ai = 0; ai < 2; ++ai) {
            f32x4 xv[4][2][2];
#pragma unroll
            for (int m = 0; m < 4; ++m)
#pragma unroll
                for (int bj = 0; bj < 2; ++bj)
#pragma unroll
                    for (int n = 0; n < 2; ++n) xv[m][bj][n] = __builtin_nontemporal_load((const f32x4*)(xp + (size_t)(row0 + ai * HALF + m * 16) * DM + col0 + bj * HALF + n * 16));
            asm volatile("" ::: "memory");
#pragma unroll
            for (int m = 0; m < 4; ++m) { const int r = row0 + ai * HALF + m * 16; const size_t off = (size_t)r * DM + col0;
                float ss = 0.f;
#pragma unroll
                for (int bj = 0; bj < 2; ++bj)
#pragma unroll
                    for (int n = 0; n < 2; ++n) { const f32x4 o = xv[m][bj][n] + acc[ai][bj][m][n];
                        ss += (o[0] * o[0] + o[1] * o[1]) + (o[2] * o[2] + o[3] * o[3]);
                        u32x2 pk; pk.x = cvt_pk_bf16(o[0], o[1]); pk.y = cvt_pk_bf16(o[2], o[3]);
                        *(u32x2*)(X1b + off + bj * HALF + n * 16) = pk; }
                ss += __shfl_xor(ss, 16); ss += __shfl_xor(ss, 32);
                if (fq == 0) SSQ[(size_t)r * 32 + u.pn * 4 + wc] = ss; }
        }
    }
};
struct EpiSwiGLU {
    static constexpr int REPS = REP_E3; static constexpr bool PERM = false, AFTER_DRAIN = false;
    const float* SSQ; bf16_t* H;
    __device__ __forceinline__ void operator()(const f32x4 (&acc)[2][2][4][2], const Unit& u, int wr, int wc, int fr, int fq) const {
        const int row0 = u.pm * BM + wr * 64 + fr, col0 = u.pn * HALF + wc * 32 + 8 * fq;
#pragma unroll
        for (int ai = 0; ai < 2; ++ai)
#pragma unroll
            for (int m = 0; m < 4; ++m) { const int r = row0 + ai * HALF + m * 16;
                const f32x4* sp = (const f32x4*)(SSQ + (size_t)r * 32 + fq * 8); const f32x4 a = sp[0], b = sp[1];
                float s = ((a[0] + a[1]) + (a[2] + a[3])) + ((b[0] + b[1]) + (b[2] + b[3]));
                s += __shfl_xor(s, 16); s += __shfl_xor(s, 32);
                const float rstd = __builtin_amdgcn_rsqf(s * (1.0f / DM) + EPS);
                float hv[8];
#pragma unroll
                for (int n = 0; n < 2; ++n)
#pragma unroll
                    for (int j = 0; j < 4; ++j) { const float gt = acc[ai][0][m][n][j] * rstd, up = acc[ai][1][m][n][j] * rstd;
                        hv[n * 4 + j] = gt * up * __builtin_amdgcn_rcpf(1.0f + __expf(-gt)); }
                u32x4 w; w.x = cvt_pk_bf16(hv[0], hv[1]); w.y = cvt_pk_bf16(hv[2], hv[3]); w.z = cvt_pk_bf16(hv[4], hv[5]); w.w = cvt_pk_bf16(hv[6], hv[7]);
                *(u32x4*)(H + (size_t)r * DFF + col0) = w; }
    }
};
struct EpiOut {
    static constexpr int REPS = REP_E4; static constexpr bool PERM = false, AFTER_DRAIN = false;
    const bf16_t* X1b; float* out;
    __device__ __forceinline__ void operator()(const f32x4 (&acc)[2][2][4][2], const Unit& u, int wr, int wc, int fr, int fq) const {
        const int row0 = u.pm * BM + wr * 64 + fr, col0 = u.pn * BM + wc * 32 + 4 * fq;
        u32x2 xw[2][4][2][2];
#pragma unroll
        for (int ai = 0; ai < 2; ++ai)
#pragma unroll
            for (int m = 0; m < 4; ++m)
#pragma unroll
                for (int bj = 0; bj < 2; ++bj)
#pragma unroll
                    for (int n = 0; n < 2; ++n) xw[ai][m][bj][n] = *(const u32x2*)(X1b + (size_t)(row0 + ai * HALF + m * 16) * DM + col0 + bj * HALF + n * 16);
        asm volatile("" ::: "memory");
#pragma unroll
        for (int ai = 0; ai < 2; ++ai)
#pragma unroll
            for (int m = 0; m < 4; ++m) { const size_t off = (size_t)(row0 + ai * HALF + m * 16) * DM + col0;
#pragma unroll
                for (int bj = 0; bj < 2; ++bj)
#pragma unroll
                    for (int n = 0; n < 2; ++n) { const u32x2 w = xw[ai][m][bj][n];
                        const f32x4 xv = (f32x4){__builtin_bit_cast(float, w.x << 16), __builtin_bit_cast(float, w.x & 0xffff0000u), __builtin_bit_cast(float, w.y << 16), __builtin_bit_cast(float, w.y & 0xffff0000u)};
                        __builtin_nontemporal_store(xv + acc[ai][bj][m][n], (f32x4*)(out + off + bj * HALF + n * 16)); } }
    }
};

template <class Epi, class Sched, bool ALIGN_EPI = false, bool SP2 = false>
__device__ __forceinline__ void gemm_phase(PG8_LAS unsigned char* lds, const Gemm g, const Sched& S, const Epi& E) {
    int tid_ = threadIdx.x; asm volatile("" : "+v"(tid_));
    const int tid = tid_, wid = __builtin_amdgcn_readfirstlane(tid >> 6), lane = tid & 63, wr = wid >> 2, wc = wid & 3, fr = lane & 15, fq = lane >> 4;
    const int K = g.K, nt = K / BK;
    unsigned voffA[2], voffB[2];
#pragma unroll
    for (int i = 0; i < 2; ++i) { int R, C;
#if PG8_ROWMAJOR
        { const int b_ = tid * 16 + i * 8192; R = b_ >> 7; C = 8 * (((b_ >> 4) & 7) ^ ((R >> 1) & 7)); }
#else
        stage_rc(tid * 16 + i * 8192, R, C);
#endif
        const int Rb = Epi::PERM ? ((R & ~31) + perm32(R & 31)) : R;
        voffA[i] = (unsigned)(R * K + C) * 2u; voffB[i] = (unsigned)(Rb * K + C) * 2u; }
    const size_t kstep = (size_t)(BK * 2);
    const size_t hstep = (size_t)HALF * K * 2;
    const size_t tstep = 2 * hstep;
    const unsigned ldsw = (unsigned)wid * 1024u;
#if PG8_ROWMAJOR
    const int aoff = (wr * 64 + fr) * 128 + 16 * (fq ^ ((fr >> 1) & 7)), boff = (wc * 32 + fr) * 128 + 16 * (fq ^ ((fr >> 1) & 7));
#define PG8_KOFF(base, k) ((base) ^ ((k) * 64))
#else
    const int aoff = lds_byte(wr * 64 + fr, fq * 8), boff = lds_byte(wc * 32 + fr, fq * 8);
#define PG8_KOFF(base, k) ((base) + (k) * 1024)
#endif
#define PG8_SA(b, h) (((b) * 2 + (h)) * HTB)
#define PG8_SB(b, h) ((4 + (b) * 2 + (h)) * HTB)
#define PG8_STAGE(bufoff, gbase, voff) do { _Pragma("unroll") for (int _i = 0; _i < 2; ++_i) \
        __builtin_amdgcn_global_load_lds((const unsigned*)((const char*)(gbase) + (voff)[_i]), (PG8_LAS unsigned*)(lds + (bufoff) + ldsw + _i * 8192), 16, 0, 0); } while (0)
#define PG8_LDA(dst, b, h) do { _Pragma("unroll") for (int m = 0; m < 4; ++m) _Pragma("unroll") for (int k = 0; k < 2; ++k) dst[m][k] = *(const PG8_LAS bf16x8*)(lds + PG8_SA(b, h) + PG8_KOFF(aoff, k) + m * 2048); } while (0)
#define PG8_LDB(dst, b, h) do { _Pragma("unroll") for (int n = 0; n < 2; ++n) _Pragma("unroll") for (int k = 0; k < 2; ++k) dst[n][k] = *(const PG8_LAS bf16x8*)(lds + PG8_SB(b, h) + PG8_KOFF(boff, k) + n * 2048); } while (0)
#define PG8_MMA(ai, bj, At, Bt) do { __builtin_amdgcn_s_setprio(1); _Pragma("unroll") for (int m = 0; m < 4; ++m) _Pragma("unroll") for (int n = 0; n < 2; ++n) _Pragma("unroll") for (int k = 0; k < 2; ++k) \
        acc[ai][bj][m][n] = __builtin_amdgcn_mfma_f32_16x16x32_bf16(Bt[n][k], At[m][k], acc[ai][bj][m][n], 0, 0, 0); __builtin_amdgcn_s_setprio(0); } while (0)
#define PG8_WAIT_V(n) asm volatile("s_waitcnt vmcnt(" #n ")" ::: "memory")
#define PG8_WAIT_L(n) asm volatile("s_waitcnt lgkmcnt(" #n ")" ::: "memory")
#define PG8_BAR __builtin_amdgcn_s_barrier()
#define PG8_SCHED __builtin_amdgcn_sched_barrier(0)
    Unit cur, nxt; int ui = 0;
    if (!S.next(0, cur)) return;
    f32x4 acc[2][2][4][2];
#pragma unroll
    for (int a = 0; a < 2; ++a)
#pragma unroll
        for (int b = 0; b < 2; ++b)
#pragma unroll
            for (int m = 0; m < 4; ++m)
#pragma unroll
                for (int n = 0; n < 2; ++n) acc[a][b][m][n] = (f32x4){0.f, 0.f, 0.f, 0.f};
    bf16x8 At[4][2], B0[2][2], B1[2][2];
    const char* cA = (const char*)g.A + (size_t)cur.pm * tstep; const char* cB = (const char*)g.Bt + (size_t)cur.pn * tstep;
    S.a_ready(cur);
    if constexpr (SP2) {
        PG8_STAGE(PG8_SB(0, 0), cB, voffB); PG8_STAGE(PG8_SB(0, 1), cB + hstep, voffB); PG8_STAGE(PG8_SA(0, 0), cA, voffA); PG8_STAGE(PG8_SA(0, 1), cA + hstep, voffA);
        if (wr == 1) PG8_BAR;
        PG8_WAIT_V(2); PG8_BAR;
        PG8_STAGE(PG8_SB(1, 0), cB + kstep, voffB); PG8_STAGE(PG8_SA(1, 0), cA + kstep, voffA); PG8_STAGE(PG8_SB(1, 1), cB + hstep + kstep, voffB);
        PG8_WAIT_V(6); PG8_BAR;
    } else {
        PG8_STAGE(PG8_SB(0, 0), cB, voffB); PG8_STAGE(PG8_SA(0, 0), cA, voffA); PG8_STAGE(PG8_SB(0, 1), cB + hstep, voffB); PG8_STAGE(PG8_SA(0, 1), cA + hstep, voffA);
        if (wr == 1) PG8_BAR;
        PG8_WAIT_V(4); PG8_BAR;
        PG8_STAGE(PG8_SB(1, 0), cB + kstep, voffB); PG8_STAGE(PG8_SA(1, 0), cA + kstep, voffA); PG8_STAGE(PG8_SB(1, 1), cB + hstep + kstep, voffB);
        PG8_WAIT_V(6); PG8_BAR;
    }
    for (;;) {
        const bool has_next = S.next(ui + 1, nxt);
        const char* nA = has_next ? (const char*)g.A + (size_t)nxt.pm * tstep : cA; const char* nB = has_next ? (const char*)g.Bt + (size_t)nxt.pn * tstep : cB;
        for (int t = 0; t < nt; t += 2) {
            const bool last = (t == nt - 2);
            const char* a1 = cA + (size_t)(t + 1) * kstep;
            const char* a2 = last ? nA : cA + (size_t)(t + 2) * kstep; const char* b2 = last ? nB : cB + (size_t)(t + 2) * kstep;
            const char* a3 = a2 + kstep; const char* b3 = b2 + kstep;
            if (last && has_next) S.a_ready(nxt);
            if constexpr (SP2) {
            PG8_LDB(B0, 0, 0); PG8_LDB(B1, 0, 1); PG8_SCHED; PG8_LDA(At, 0, 0); PG8_STAGE(PG8_SA(1, 1), a1 + hstep, voffA);
            PG8_WAIT_V(8); PG8_WAIT_L(0); PG8_BAR; PG8_MMA(0, 0, At, B0); PG8_MMA(0, 1, At, B1); PG8_BAR; PG8_SCHED;
            PG8_LDA(At, 0, 1); PG8_STAGE(PG8_SB(0, 0), b2, voffB); PG8_STAGE(PG8_SB(0, 1), b2 + hstep, voffB); PG8_STAGE(PG8_SA(0, 0), a2, voffA);
            PG8_WAIT_V(8); PG8_WAIT_L(0); PG8_BAR; PG8_MMA(1, 0, At, B0); PG8_MMA(1, 1, At, B1); PG8_BAR; PG8_SCHED;
            PG8_LDB(B0, 1, 0); PG8_LDB(B1, 1, 1); PG8_SCHED; PG8_LDA(At, 1, 0); PG8_STAGE(PG8_SA(0, 1), a2 + hstep, voffA);
            PG8_WAIT_V(8); PG8_WAIT_L(0); PG8_BAR; PG8_MMA(0, 0, At, B0); PG8_MMA(0, 1, At, B1); PG8_BAR; PG8_SCHED;
            PG8_LDA(At, 1, 1); PG8_STAGE(PG8_SB(1, 0), b3, voffB); PG8_STAGE(PG8_SB(1, 1), b3 + hstep, voffB); PG8_STAGE(PG8_SA(1, 0), a3, voffA);
            PG8_WAIT_V(8); PG8_WAIT_L(0); PG8_BAR; PG8_MMA(1, 0, At, B0); PG8_MMA(1, 1, At, B1); PG8_BAR; PG8_SCHED;
            } else {
            PG8_LDB(B0, 0, 0); PG8_SCHED; PG8_LDA(At, 0, 0); PG8_STAGE(PG8_SA(1, 1), a1 + hstep, voffA);
            PG8_WAIT_L(8); PG8_BAR; PG8_WAIT_L(0); PG8_MMA(0, 0, At, B0); PG8_BAR; PG8_SCHED;
            PG8_LDB(B1, 0, 1); PG8_STAGE(PG8_SB(0, 0), b2, voffB);
            PG8_BAR; PG8_WAIT_L(0); PG8_MMA(0, 1, At, B1); PG8_BAR;
            PG8_LDA(At, 0, 1); PG8_STAGE(PG8_SA(0, 0), a2, voffA);
            PG8_BAR; PG8_WAIT_L(0); PG8_MMA(1, 0, At, B0); PG8_BAR; PG8_SCHED;
            PG8_STAGE(PG8_SB(0, 1), b2 + hstep, voffB);
            PG8_WAIT_V(6); PG8_BAR; PG8_MMA(1, 1, At, B1); PG8_BAR;
            PG8_LDB(B0, 1, 0); PG8_SCHED; PG8_LDA(At, 1, 0); PG8_STAGE(PG8_SA(0, 1), a2 + hstep, voffA);
            PG8_WAIT_L(8); PG8_BAR; PG8_WAIT_L(0); PG8_MMA(0, 0, At, B0); PG8_BAR; PG8_SCHED;
            PG8_LDB(B1, 1, 1); PG8_STAGE(PG8_SB(1, 0), b3, voffB);
            PG8_BAR; PG8_WAIT_L(0); PG8_MMA(0, 1, At, B1); PG8_BAR;
            PG8_LDA(At, 1, 1); PG8_STAGE(PG8_SA(1, 0), a3, voffA);
            PG8_BAR; PG8_WAIT_L(0); PG8_MMA(1, 0, At, B0); PG8_BAR; PG8_SCHED;
            PG8_STAGE(PG8_SB(1, 1), b3 + hstep, voffB);
            PG8_WAIT_V(6); PG8_BAR; PG8_MMA(1, 1, At, B1); PG8_BAR;
            }
        }
        if constexpr (ALIGN_EPI) { if (wr == 0) PG8_BAR; }
        if constexpr (!Epi::AFTER_DRAIN) { E(acc, cur, wr, wc, fr, fq); if constexpr (Epi::REPS > 1) { asm volatile("" ::: "memory"); Unit c2 = cur; int fr2 = fr, fq2 = fq; asm volatile("" : "+s"(c2.pm), "+s"(c2.pn), "+v"(fr2), "+v"(fq2)); E(acc, c2, wr, wc, fr2, fq2); } S.done(cur); }
        if (!has_next) break;
#pragma unroll
        for (int a = 0; a < 2; ++a)
#pragma unroll
            for (int b = 0; b < 2; ++b)
#pragma unroll
                for (int m = 0; m < 4; ++m)
#pragma unroll
                    for (int n = 0; n < 2; ++n) acc[a][b][m][n] = (f32x4){0.f, 0.f, 0.f, 0.f};
        cur = nxt; cA = nA; cB = nB; ++ui;
        if constexpr (ALIGN_EPI) { if (wr == 1) PG8_BAR; }
    }
    PG8_WAIT_V(0);
    if constexpr (!ALIGN_EPI) { if (wr == 0) PG8_BAR; }
    PG8_BAR;
#undef PG8_SA
#undef PG8_KOFF
#undef PG8_SB
#undef PG8_STAGE
#undef PG8_LDA
#undef PG8_LDB
#undef PG8_MMA
#undef PG8_WAIT_V
#undef PG8_WAIT_L
#undef PG8_BAR
#undef PG8_SCHED
}
}

#define GAS __attribute__((address_space(1)))
#define LAS __attribute__((address_space(3)))
typedef unsigned short bf16;
typedef unsigned v4u __attribute__((ext_vector_type(4)));
typedef unsigned v2u __attribute__((ext_vector_type(2)));
typedef float f32x4 __attribute__((ext_vector_type(4)));
typedef float f32x2 __attribute__((ext_vector_type(2)));
#define LDS_WAIT() asm volatile("s_waitcnt lgkmcnt(0)" ::: "memory")
constexpr int NWAVES = 8, NTHR = 512;
constexpr int LDS_BYTES = 160 * 1024;
constexpr int LDS_ST_OFF = LDS_BYTES - 64;

__device__ __forceinline__ int opaque_tid() { int t = threadIdx.x; asm volatile("" : "+v"(t)); return t; }
__device__ __forceinline__ unsigned f2bf(float f) { unsigned u = __builtin_bit_cast(unsigned, f); return (u + 0x7fffu + ((u >> 16) & 1u)) >> 16; }
__device__ __forceinline__ unsigned pk2(float lo, float hi) { unsigned r; asm volatile("v_cvt_pk_bf16_f32 %0, %1, %2" : "=v"(r) : "v"(lo), "v"(hi)); return r; }
__device__ __forceinline__ float bf_lo(unsigned w) { return __builtin_bit_cast(float, w << 16); }
__device__ __forceinline__ float bf_hi(unsigned w) { return __builtin_bit_cast(float, w & 0xffff0000u); }
__device__ __forceinline__ float wave_sum(float v) {
#pragma unroll
    for (int o = 1; o < 64; o <<= 1) v += __shfl_xor(v, o);
    return v;
}
__device__ __forceinline__ float wave_max(float v) {
#pragma unroll
    for (int o = 1; o < 64; o <<= 1) v = fmaxf(v, __shfl_xor(v, o));
    return v;
}

constexpr size_t MiB = 1u << 20;
constexpr size_t WS_CTL = 0;
constexpr size_t WS_WIN = 1 * MiB;
constexpr size_t WS_WOUT = 25 * MiB;
constexpr size_t WS_WGU = 33 * MiB;
constexpr size_t WS_WDN = 77 * MiB;
constexpr size_t WS_XN = 99 * MiB;
constexpr size_t WS_PROJ = 132 * MiB;
constexpr size_t WS_QN = 231 * MiB;
constexpr size_t WS_KN = 248 * MiB;
constexpr size_t WS_VT1 = 265 * MiB, WS_VT2 = 281 * MiB, WS_VT3 = 297 * MiB;
constexpr size_t WS_MIX = 313 * MiB;
constexpr size_t WS_X1 = 346 * MiB;
constexpr size_t WS_XN2 = 412 * MiB;
constexpr size_t WS_SSQ = 445 * MiB;
constexpr size_t WS_H = 447 * MiB;
constexpr size_t WS_END = 538 * MiB;

constexpr size_t O_Y = 0;
constexpr size_t O_PK = (size_t)MT * DM;
constexpr size_t O_PV = O_PK + (size_t)2048 * 1024;
constexpr size_t O_PC = O_PV + (size_t)2048 * 1024;
constexpr size_t O_SK = O_PC + 2048;
constexpr size_t O_SV = O_SK + (size_t)NSAMP * 1024;
constexpr size_t O_SC = O_SV + (size_t)NSAMP * 1024;
constexpr size_t O_END = O_SC + (size_t)DBATCH * 2 * 1024;

struct Args {
    const float* x_prompt; const float* x_sample; const float* cache_k; const float* cache_v; const float* state_conv; const float* norm_mix; const float* w_in; const float* conv_w;
    const float* q_norm; const float* k_norm; const float* rel_bias; const float* w_out; const float* norm_ffn; const float* w_gate; const float* w_up; const float* w_down;
    float* out; unsigned char* ws;
};

__device__ __forceinline__ void p0_transpose_item(const float* W, int N, int K, int c0, int k0, bf16* WT, int drow0, bool perm, LAS float* scr, int lane, const float* kscale = nullptr) {
    const int ksub = lane >> 4, n4 = lane & 15;
    f32x4 v[16];
    const GAS f32x4* src = (const GAS f32x4*)(W + (size_t)(k0 + ksub) * N + c0 + 4 * n4);
#pragma unroll
    for (int i = 0; i < 16; ++i) v[i] = __builtin_nontemporal_load(src + (size_t)i * N);
    if (kscale) {
#pragma unroll
        for (int i = 0; i < 16; ++i) v[i] = v[i] * kscale[k0 + 4 * i + ksub]; }
#pragma unroll
    for (int i = 0; i < 16; ++i) { LAS float* d = scr + (4 * i + ksub) * 65 + 4 * n4; d[0] = v[i][0]; d[1] = v[i][1]; d[2] = v[i][2]; d[3] = v[i][3]; }
    LDS_WAIT(); asm volatile("" ::: "memory");
    const int c = lane >> 3, nsub = lane & 7;
#pragma unroll
    for (int j = 0; j < 8; ++j) { const int n = nsub + 8 * j; const int ns = perm ? ((n & 32) + pg8::perm32(n & 31)) : n; const LAS float* s = scr + (8 * c) * 65 + ns;
        v4u o; o.x = pk2(s[0 * 65], s[1 * 65]); o.y = pk2(s[2 * 65], s[3 * 65]); o.z = pk2(s[4 * 65], s[5 * 65]); o.w = pk2(s[6 * 65], s[7 * 65]);
        *(GAS v4u*)(WT + (size_t)(drow0 + n) * K + k0 + 8 * c) = o; }
    LDS_WAIT(); asm volatile("" ::: "memory");
}
__device__ __forceinline__ void p0_rms_row(const float* xrow, const float* g, bf16* orow, int lane) {
    const GAS f32x4* xr = (const GAS f32x4*)xrow + lane; const GAS f32x4* gr = (const GAS f32x4*)g + lane;
    f32x4 v[8]; float s = 0.f;
#pragma unroll
    for (int j = 0; j < 8; ++j) { v[j] = __builtin_nontemporal_load(xr + 64 * j); s += (v[j].x * v[j].x + v[j].y * v[j].y) + (v[j].z * v[j].z + v[j].w * v[j].w); }
    const float rstd = 1.0f / sqrtf(wave_sum(s) * (1.f / DM) + EPS);
    GAS v2u* o8 = (GAS v2u*)orow + lane;
#pragma unroll
    for (int j = 0; j < 8; ++j) { const f32x4 gg = gr[64 * j]; v2u o; o.x = pk2(v[j].x * rstd * gg.x, v[j].y * rstd * gg.y); o.y = pk2(v[j].z * rstd * gg.z, v[j].w * rstd * gg.w); o8[64 * j] = o; }
}
__device__ __forceinline__ void phase_prologue(const Args& A, LAS unsigned char* lds, int vcu, int G) {
    const int tid = opaque_tid(), lane = tid & 63, wave = __builtin_amdgcn_readfirstlane(tid >> 6);
    LAS float* scr = (LAS float*)(lds + wave * 17408);
    const int gw = vcu * NWAVES + wave, NGW = G * NWAVES;
    bf16* WIN = (bf16*)(A.ws + WS_WIN); bf16* WOUT = (bf16*)(A.ws + WS_WOUT); bf16* WGU = (bf16*)(A.ws + WS_WGU); bf16* WDN = (bf16*)(A.ws + WS_WDN); bf16* XN = (bf16*)(A.ws + WS_XN);
    constexpr int I_IN = (DM / 64) * (DIN / 64), I_OUT = (DM / 64) * (DM / 64), I_GU = (DM / 64) * (NGU / 64), I_DN = (DFF / 64) * (DM / 64);
    constexpr int NITEMS = I_IN;
    for (int it = gw; it < NITEMS; it += NGW) { const int nb = it % (DIN / 64), kb = it / (DIN / 64); p0_transpose_item(A.w_in, DIN, DM, 64 * nb, 64 * kb, WIN, 64 * nb, false, scr, lane); }
    for (int m = gw; m < MT; m += NGW) p0_rms_row(m < SEQ ? A.x_prompt + (size_t)m * DM : A.x_sample + (size_t)(m - SEQ) * DM, A.norm_mix, XN + (size_t)m * DM, lane);
}
constexpr int PL_WO = (DM / 64) * (DM / 64) / 8, PL_GU = PL_WO + (DM / 64) * (NGU / 64) / 8;
__device__ __forceinline__ void convert_gu_item(const Args& A, LAS unsigned char* lds, int item) {
    const int tid = opaque_tid(), lane = tid & 63, wave = __builtin_amdgcn_readfirstlane(tid >> 6);
    LAS float* scr = (LAS float*)(lds + wave * 17408);
    bf16* WGU = (bf16*)(A.ws + WS_WGU);
    if (item < PL_WO) { const int r = item * 8 + wave; const int nb = r % (DM / 64), kb = r / (DM / 64); p0_transpose_item(A.w_out, DM, DM, 64 * nb, 64 * kb, (bf16*)(A.ws + WS_WOUT), 64 * nb, false, scr, lane); return; }
    item -= PL_WO;
    { const int r = item * 8 + wave; const int nb = r % (NGU / 64), kb = r / (NGU / 64);
        const int pn = nb >> 2, t = (nb >> 1) & 1, w2 = nb & 1; p0_transpose_item(t ? A.w_up : A.w_gate, DFF, DM, 128 * pn + 64 * w2, 64 * kb, WGU, 64 * nb, true, scr, lane, A.norm_ffn); }
}
__device__ __forceinline__ void convert_wdown(const Args& A, LAS unsigned char* lds, int widx, int nw) {
    const int tid = opaque_tid(), lane = tid & 63, wave = __builtin_amdgcn_readfirstlane(tid >> 6);
    LAS float* scr = (LAS float*)(lds + wave * 17408);
    bf16* WDN = (bf16*)(A.ws + WS_WDN);
    constexpr int I_DN = (DFF / 64) * (DM / 64);
    for (int r = widx * NWAVES + wave; r < I_DN; r += nw * NWAVES) { const int nb = r % (DM / 64), kb = r / (DM / 64); p0_transpose_item(A.w_down, DM, DFF, 64 * nb, 64 * kb, WDN, 64 * nb, false, scr, lane); }
}

__device__ __forceinline__ void unpack8(const v4u w, float* f) { f[0] = bf_lo(w.x); f[1] = bf_hi(w.x); f[2] = bf_lo(w.y); f[3] = bf_hi(w.y); f[4] = bf_lo(w.z); f[5] = bf_hi(w.z); f[6] = bf_lo(w.w); f[7] = bf_hi(w.w); }
__device__ __forceinline__ float softmax_bound_l2(const Args& A, int lane) {
    float mq = fmaxf(fabsf(A.q_norm[lane]), fabsf(A.q_norm[lane + 64])), mk = fmaxf(fabsf(A.k_norm[lane]), fabsf(A.k_norm[lane + 64]));
    float mb = fmaxf(fmaxf(fabsf(A.rel_bias[lane]), fabsf(A.rel_bias[lane + 64])), fmaxf(fabsf(A.rel_bias[lane + 128]), fabsf(A.rel_bias[lane + 192])));
    mq = wave_max(mq); mk = wave_max(mk); mb = wave_max(mb);
    return LOG2E * (11.313708498984761f * mq * mk * 1.01f + mb);
}
typedef short bf16x8 __attribute__((ext_vector_type(8)));
__device__ __forceinline__ bf16x8 ld16(const bf16* p) { return __builtin_bit_cast(bf16x8, *(const GAS v4u*)p); }
typedef short s16x4 __attribute__((ext_vector_type(4)));
constexpr int AT_STAGE = 65536, AT_VOFF = 32768, AT_TBL = 131072;
__device__ __forceinline__ int swz_f(int row) { return (((row ^ (row >> 2) ^ (row >> 4)) & 1) << 1) | ((((row >> 1) ^ (row >> 5)) & 1) << 2) | ((((row >> 3) ^ (row >> 6)) & 1) << 3); }
__device__ __forceinline__ void attn2_stage(LAS unsigned char* lds, int buf, const bf16* Kg, const bf16* Vg, int P0, int wave, int lane) {
#pragma unroll
    for (int i = 0; i < 4; ++i) { const int row = (wave * 4 + i) * 4 + (lane >> 4), c = (lane & 15) ^ swz_f(row);
        __builtin_amdgcn_global_load_lds((const unsigned*)(Kg + (size_t)(P0 + row) * 1024 + 8 * c), (LAS unsigned*)(lds + buf * AT_STAGE + (wave * 4 + i) * 1024), 16, 0, 0); }
#pragma unroll
    for (int i = 0; i < 4; ++i) { const int row = (wave * 4 + i) * 4 + (lane >> 4), c = (lane & 15) ^ swz_f(row);
        __builtin_amdgcn_global_load_lds((const unsigned*)(Vg + (size_t)(P0 + row) * DIN + 8 * c), (LAS unsigned*)(lds + buf * AT_STAGE + AT_VOFF + (wave * 4 + i) * 1024), 16, 0, 0); }
}
template <bool HALF, int CX, int OFF>
__device__ __forceinline__ void attn5_block(const LAS unsigned char* Kb, const LAS unsigned char* Vb, unsigned ko0, unsigned ko1, unsigned voA, unsigned voB, const bf16x8 (&qf)[4], f32x4 (&o)[8], float& lsum, const LAS float* tj) {
    f32x4 s0 = (f32x4){tj[0], tj[-1], tj[-2], tj[-3]}, s1 = HALF ? (f32x4){0.f, 0.f, 0.f, 0.f} : (f32x4){tj[-4], tj[-5], tj[-6], tj[-7]};
    {   bf16x8 kf0[4];
#pragma unroll
        for (int ks = 0; ks < 4; ++ks) kf0[ks] = *(const LAS bf16x8*)(Kb + (ko0 ^ (unsigned)(64 * ks ^ CX)) + OFF);
        if (!HALF) { bf16x8 kf1[4];
#pragma unroll
            for (int ks = 0; ks < 4; ++ks) kf1[ks] = *(const LAS bf16x8*)(Kb + (ko1 ^ (unsigned)(64 * ks ^ CX)) + OFF);
#pragma unroll
            for (int ks = 0; ks < 4; ++ks) { s0 = __builtin_amdgcn_mfma_f32_16x16x32_bf16(kf0[ks], qf[ks], s0, 0, 0, 0); s1 = __builtin_amdgcn_mfma_f32_16x16x32_bf16(kf1[ks], qf[ks], s1, 0, 0, 0); }
        } else {
#pragma unroll
            for (int ks = 0; ks < 4; ++ks) s0 = __builtin_amdgcn_mfma_f32_16x16x32_bf16(kf0[ks], qf[ks], s0, 0, 0, 0);
        }
    }
    float pv[8];
#pragma unroll
    for (int e = 0; e < (HALF ? 4 : 8); ++e) { const float sv = e < 4 ? s0[e] : s1[e - 4]; pv[e] = __builtin_amdgcn_exp2f(sv); lsum += pv[e]; }
    v4u pw; pw.x = pg8::cvt_pk_bf16(pv[0], pv[1]); pw.y = pg8::cvt_pk_bf16(pv[2], pv[3]);
    if (HALF) { pw.z = 0u; pw.w = 0u; } else { pw.z = pg8::cvt_pk_bf16(pv[4], pv[5]); pw.w = pg8::cvt_pk_bf16(pv[6], pv[7]); }
    const bf16x8 pf = __builtin_bit_cast(bf16x8, pw);
    const unsigned vA = (unsigned)(size_t)Vb + voA, vB = (unsigned)(size_t)Vb + voB;
    s16x4 va[8], vb[8];
#pragma unroll
    for (int dt = 0; dt < 8; ++dt) {
        asm volatile("ds_read_b64_tr_b16 %0, %1 offset:%2" : "=v"(va[dt]) : "v"(vA ^ (unsigned)(32 * dt ^ CX)), "i"(OFF));
        if (!HALF) asm volatile("ds_read_b64_tr_b16 %0, %1 offset:%2" : "=v"(vb[dt]) : "v"(vB ^ (unsigned)(32 * dt ^ CX)), "i"(OFF));
        else vb[dt] = (s16x4){0, 0, 0, 0};
    }
    if (!HALF) asm volatile("s_waitcnt lgkmcnt(0)" : "+v"(va[0]), "+v"(va[1]), "+v"(va[2]), "+v"(va[3]), "+v"(va[4]), "+v"(va[5]), "+v"(va[6]), "+v"(va[7]), "+v"(vb[0]), "+v"(vb[1]), "+v"(vb[2]), "+v"(vb[3]), "+v"(vb[4]), "+v"(vb[5]), "+v"(vb[6]), "+v"(vb[7]) :: "memory");
    else asm volatile("s_waitcnt lgkmcnt(0)" : "+v"(va[0]), "+v"(va[1]), "+v"(va[2]), "+v"(va[3]), "+v"(va[4]), "+v"(va[5]), "+v"(va[6]), "+v"(va[7]) :: "memory");
    __builtin_amdgcn_sched_barrier(0);
#pragma unroll
    for (int dt = 0; dt < 8; ++dt) {
        const bf16x8 vf = (bf16x8){va[dt][0], va[dt][1], va[dt][2], va[dt][3], vb[dt][0], vb[dt][1], vb[dt][2], vb[dt][3]};
        o[dt] = __builtin_amdgcn_mfma_f32_16x16x32_bf16(vf, pf, o[dt], 0, 0, 0);
    }
}
__device__ __forceinline__ const LAS float* tbl_at(const LAS float* tb, int jb) { const int jc = jb < -1 ? -1 : (jb > 137 ? 137 : jb); return tb + jc; }
template <int BUF>
__device__ __forceinline__ void attn2_chunk(LAS unsigned char* lds, const bf16* Kg, const bf16* Vg, int t0, int j, int r0, int wave, int lane, const bf16x8 (&qf)[2][4], f32x4 (&o)[2][8], float (&lsum)[2]) {
    const int Pj = t0 - 2048 + 128 * j;
    if (j + 1 < 18) attn2_stage(lds, BUF ^ 1, Kg, Vg, Pj + 128, wave, lane);
    asm volatile("" ::: "memory");
    const LAS unsigned char* Kb = lds + BUF * AT_STAGE; const LAS unsigned char* Vb = lds + BUF * AT_STAGE + AT_VOFF;
    const LAS float* tbl = (const LAS float*)(lds + AT_TBL);
#pragma unroll
    for (int gi = 0; gi < 2; ++gi) { const int r = r0 + gi;
        int l2 = lane; asm volatile("" : "+v"(l2));
        const int li2 = l2 & 15, qd2 = l2 >> 4, q2 = li2 >> 2, p2 = li2 & 3; const unsigned pt = 8u * (p2 & 1);
        {
            const int row = r + 16 * (li2 & 7), rowA = r + 16 * ((4 * qd2 + q2) & 7);
            const unsigned ko0 = row * 256 + 16 * (qd2 ^ swz_f(row)), voA = rowA * 256 + 16 * ((p2 >> 1) ^ swz_f(rowA)) + pt;
            attn5_block<true, 0, 0>(Kb, Vb, ko0, 0u, voA, 0u, qf[gi], o[gi], lsum[gi], tbl_at(tbl + 2 * 148 + 8, qd2 < 2 ? ((t0 - Pj) >> 4) + li2 - 4 * qd2 : 100000)); }
        if (j >= 12) {
            const int row0 = (r & 3) + 4 * (8 * q2 + p2), row1 = row0 + 16, rowA = (r & 3) + 4 * (8 * qd2 + q2), rowB = rowA + 16;
            const unsigned ko0 = row0 * 256 + 16 * (qd2 ^ swz_f(row0)), ko1 = row1 * 256 + 16 * (qd2 ^ swz_f(row1)), voA = rowA * 256 + 16 * ((p2 >> 1) ^ swz_f(rowA)) + pt, voB = rowB * 256 + 16 * ((p2 >> 1) ^ swz_f(rowB)) + pt;
            attn5_block<false, 0, 0>(Kb, Vb, ko0, ko1, voA, voB, qf[gi], o[gi], lsum[gi], tbl_at(tbl + 148 + 8, ((t0 - Pj) >> 2) + (r >> 2) + 4 * li2 - 8 * qd2)); }
        if (j >= 15) {
            const int row0 = 8 * q2 + p2, row1 = row0 + 4, rowA = 8 * qd2 + q2, rowB = rowA + 4;
            const unsigned ko0 = row0 * 256 + 16 * (qd2 ^ swz_f(row0)), ko1 = row1 * 256 + 16 * (qd2 ^ swz_f(row1)), voA = rowA * 256 + 16 * ((p2 >> 1) ^ swz_f(rowA)) + pt, voB = rowB * 256 + 16 * ((p2 >> 1) ^ swz_f(rowB)) + pt;
            const int jb0 = (t0 - Pj) + r + 16 * li2 - 8 * qd2; const LAS float* tb1 = tbl + 8;
            attn5_block<false, 0, 0>(Kb, Vb, ko0, ko1, voA, voB, qf[gi], o[gi], lsum[gi], tbl_at(tb1, jb0));
            attn5_block<false, 64, 8192>(Kb, Vb, ko0, ko1, voA, voB, qf[gi], o[gi], lsum[gi], tbl_at(tb1, jb0 - 32));
            attn5_block<false, 128, 16384>(Kb, Vb, ko0, ko1, voA, voB, qf[gi], o[gi], lsum[gi], tbl_at(tb1, jb0 - 64));
            attn5_block<false, 192, 24576>(Kb, Vb, ko0, ko1, voA, voB, qf[gi], o[gi], lsum[gi], tbl_at(tb1, jb0 - 96)); }
    }
    asm volatile("s_waitcnt vmcnt(0) lgkmcnt(0)" ::: "memory");
    __builtin_amdgcn_s_barrier(); asm volatile("" ::: "memory");
}
constexpr int FR_SLOT = 4096, FR_WAVE = 4 * FR_SLOT;
__device__ __forceinline__ void far_stage(LAS unsigned char* ring, int slot, const bf16* Kg, const bf16* Vg, int pos0, int lane) {
#pragma unroll
    for (int i = 0; i < 4; ++i) { const int row = 4 * (i & 1) + (lane >> 4), c = (lane & 15) ^ (2 * row);
        const bf16* src = (i < 2 ? Kg + (size_t)(pos0 + 16 * row) * 1024 : Vg + (size_t)(pos0 + 16 * row) * DIN) + 8 * c;
        __builtin_amdgcn_global_load_lds((const unsigned*)src, (LAS unsigned*)(ring + slot * FR_SLOT + i * 1024), 16, 0, 0); }
}
template <int S>
__device__ __forceinline__ void far_step(LAS unsigned char* lds, LAS unsigned char* ring, const bf16* Kg, const bf16* Vg, int t0, int jmin, int r0, int gc, int ngc, int lane, const bf16x8 (&qf)[2][4], f32x4 (&o)[2][8], float (&lsum)[2]) {
    constexpr int gi = S & 1;
    if (gc + 3 < ngc) { const int x = gc + 3; far_stage(ring, (S + 3) & 3, Kg, Vg, t0 - 2048 + 128 * (jmin + (x >> 1)) + r0 + (x & 1), lane); asm volatile("s_waitcnt vmcnt(12)" ::: "memory"); }
    else if (gc + 2 < ngc) asm volatile("s_waitcnt vmcnt(8)" ::: "memory");
    else if (gc + 1 < ngc) asm volatile("s_waitcnt vmcnt(4)" ::: "memory");
    else asm volatile("s_waitcnt vmcnt(0)" ::: "memory");
    const int Pj = t0 - 2048 + 128 * (jmin + (gc >> 1));
    int l2 = lane; asm volatile("" : "+v"(l2));
    const int li2 = l2 & 15, qd2 = l2 >> 4, q2 = li2 >> 2, p2 = li2 & 3, k = li2 & 7, kA = (4 * qd2 + q2) & 7;
    const unsigned ko0 = k * 256 + 16 * (qd2 ^ (2 * k)), voA = kA * 256 + 16 * ((p2 >> 1) ^ (2 * kA)) + 8u * (p2 & 1);
    const LAS unsigned char* Kb = ring + S * FR_SLOT;
    attn5_block<true, 0, 0>(Kb, Kb + 2048, ko0, 0u, voA, 0u, qf[gi], o[gi], lsum[gi], tbl_at((const LAS float*)(lds + AT_TBL) + 2 * 148 + 8, qd2 < 2 ? ((t0 - Pj) >> 4) + li2 - 4 * qd2 : 100000));
    asm volatile("s_waitcnt lgkmcnt(0)" ::: "memory");
}
__device__ __forceinline__ void attn2_prompt_unit(const Args& A, LAS unsigned char* lds, int h, int qt, float Mp) {
    const int tid = opaque_tid(), lane = tid & 63, wave = __builtin_amdgcn_readfirstlane(tid >> 6), li = lane & 15, quad = lane >> 4;
    const bf16* QN = (const bf16*)(A.ws + WS_QN); bf16* MIX = (bf16*)(A.ws + WS_MIX);
    const bf16* Kg = (const bf16*)(A.ws + WS_KN) + h * HD; const bf16* Vg = (const bf16*)(A.ws + WS_PROJ) + 5120 + h * HD;
    LAS float* tbl = (LAS float*)(lds + AT_TBL);
    __syncthreads();
    for (int x = tid; x < 3 * 148; x += NTHR) { const int g = x / 148, jj = x % 148 - 8; float v = -1e30f; if (jj >= 0 && jj <= 128) v = A.rel_bias[BUCKET[g][jj] * NH + h] * LOG2E - Mp; tbl[x] = v; }
    const int t0 = qt * 256, r0 = 2 * wave;
    bf16x8 qf[2][4]; f32x4 o[2][8]; float lsum[2] = {0.f, 0.f};
#pragma unroll
    for (int gi = 0; gi < 2; ++gi) {
#pragma unroll
        for (int ks = 0; ks < 4; ++ks) qf[gi][ks] = ld16(QN + (size_t)(t0 + 16 * li + r0 + gi) * 1024 + h * HD + 32 * ks + 8 * quad);
#pragma unroll
        for (int dt = 0; dt < 8; ++dt) o[gi][dt] = (f32x4){0.f, 0.f, 0.f, 0.f};
    }
    asm volatile("s_waitcnt vmcnt(0) lgkmcnt(0)" ::: "memory");
    __syncthreads();
    const int jmin = (16 - 2 * qt) > 0 ? (16 - 2 * qt) : 0;
    const int jn = jmin > 12 ? jmin : 12;
    if (jmin < 12) {
        LAS unsigned char* ring = lds + wave * FR_WAVE; const int ngc = 2 * (12 - jmin);
        far_stage(ring, 0, Kg, Vg, t0 - 2048 + 128 * jmin + r0, lane); far_stage(ring, 1, Kg, Vg, t0 - 2048 + 128 * jmin + r0 + 1, lane); far_stage(ring, 2, Kg, Vg, t0 - 2048 + 128 * (jmin + 1) + r0, lane);
#pragma unroll 1
        for (int gc = 0; gc < ngc; gc += 4) {
            far_step<0>(lds, ring, Kg, Vg, t0, jmin, r0, gc, ngc, lane, qf, o, lsum); far_step<1>(lds, ring, Kg, Vg, t0, jmin, r0, gc + 1, ngc, lane, qf, o, lsum);
            far_step<2>(lds, ring, Kg, Vg, t0, jmin, r0, gc + 2, ngc, lane, qf, o, lsum); far_step<3>(lds, ring, Kg, Vg, t0, jmin, r0, gc + 3, ngc, lane, qf, o, lsum);
        }
        asm volatile("s_waitcnt vmcnt(0) lgkmcnt(0)" ::: "memory");
        __builtin_amdgcn_s_barrier(); asm volatile("" ::: "memory");
    }
    attn2_stage(lds, 0, Kg, Vg, t0 - 2048 + 128 * jn, wave, lane);
    asm volatile("s_waitcnt vmcnt(0)" ::: "memory");
    __builtin_amdgcn_s_barrier(); asm volatile("" ::: "memory");
#pragma unroll 1
    for (int j = jn; j < 18; j += 2) {
        attn2_chunk<0>(lds, Kg, Vg, t0, j, r0, wave, lane, qf, o, lsum);
        attn2_chunk<1>(lds, Kg, Vg, t0, j + 1, r0, wave, lane, qf, o, lsum);
    }
#pragma unroll
    for (int gi = 0; gi < 2; ++gi) {
        float l = lsum[gi]; l += __shfl_xor(l, 16); l += __shfl_xor(l, 32);
        const float inv = 1.0f / l;
        bf16* orow = MIX + (size_t)(t0 + 16 * li + r0 + gi) * DM + DATT + h * HD + 4 * quad;
#pragma unroll
        for (int dt = 0; dt < 8; ++dt) { v2u w; w.x = pg8::cvt_pk_bf16(o[gi][dt][0] * inv, o[gi][dt][1] * inv); w.y = pg8::cvt_pk_bf16(o[gi][dt][2] * inv, o[gi][dt][3] * inv); *(GAS v2u*)(orow + 16 * dt) = w; }
    }
}
__device__ __forceinline__ void load_q_frags(bf16x8 (&qf)[4], const bf16* qrow, const float* gq, int quad, float scale = QSCALE) {
    float f[32];
#pragma unroll
    for (int ks = 0; ks < 4; ++ks) unpack8(*(const GAS v4u*)(qrow + 32 * ks + 8 * quad), f + 8 * ks);
    float ss = 0.f;
#pragma unroll
    for (int i = 0; i < 32; ++i) ss += f[i] * f[i];
    ss += __shfl_xor(ss, 16); ss += __shfl_xor(ss, 32);
    const float sc = scale / sqrtf(ss * (1.f / HD) + EPS);
#pragma unroll
    for (int ks = 0; ks < 4; ++ks) { const f32x4 g0 = *(const GAS f32x4*)(gq + 32 * ks + 8 * quad), g1 = *(const GAS f32x4*)(gq + 32 * ks + 8 * quad + 4); const float* e = f + 8 * ks;
        v4u w; w.x = pg8::cvt_pk_bf16(e[0] * sc * g0[0], e[1] * sc * g0[1]); w.y = pg8::cvt_pk_bf16(e[2] * sc * g0[2], e[3] * sc * g0[3]); w.z = pg8::cvt_pk_bf16(e[4] * sc * g1[0], e[5] * sc * g1[1]); w.w = pg8::cvt_pk_bf16(e[6] * sc * g1[2], e[7] * sc * g1[3]);
        qf[ks] = __builtin_bit_cast(bf16x8, w); }
}
constexpr int PL_KV = (WBUF + NSAMP) / 32, PL_CONV = MT / 16, PL_ITEMS = PL_KV + PL_CONV;
__device__ __forceinline__ void postlite_item(const Args& A, int item) {
    const int tid = opaque_tid(), lane = tid & 63, wave = __builtin_amdgcn_readfirstlane(tid >> 6);
    const bf16* PROJ = (const bf16*)(A.ws + WS_PROJ); bf16* MIX = (bf16*)(A.ws + WS_MIX);
    if (item < PL_KV) {
        v4u kw[4][2], vw[4][2];
#pragma unroll
        for (int q = 0; q < 4; ++q) { const int tk_ = (SEQ - WBUF) + item * 32 + wave * 4 + q; const bf16* prow = PROJ + (size_t)tk_ * DIN; const GAS v4u* pk = tk_ >= SEQ ? (const GAS v4u*)(prow + 4096 + lane * 16) : (const GAS v4u*)((const bf16*)(A.ws + WS_KN) + (size_t)tk_ * 1024 + lane * 16); const GAS v4u* pv = (const GAS v4u*)(prow + 5120 + lane * 16);
            kw[q][0] = pk[0]; kw[q][1] = pk[1]; vw[q][0] = pv[0]; vw[q][1] = pv[1]; }
        f32x4 g[4];
#pragma unroll
        for (int j = 0; j < 4; ++j) g[j] = *(const GAS f32x4*)(A.k_norm + (lane & 7) * 16 + 4 * j);
#pragma unroll
        for (int q = 0; q < 4; ++q) { const int tok = (SEQ - WBUF) + item * 32 + wave * 4 + q;
            float* ko; float* vo;
            if (tok >= SEQ) { ko = A.out + O_SK + (size_t)(tok - SEQ) * 1024; vo = A.out + O_SV + (size_t)(tok - SEQ) * 1024; }
            else { ko = A.out + O_PK + (size_t)(tok - (SEQ - WBUF)) * 1024; vo = A.out + O_PV + (size_t)(tok - (SEQ - WBUF)) * 1024; }
            float f[16]; unpack8(kw[q][0], f); unpack8(kw[q][1], f + 8);
            float ss = 0.f;
#pragma unroll
            for (int j = 0; j < 16; ++j) ss += f[j] * f[j];
            ss += __shfl_xor(ss, 1); ss += __shfl_xor(ss, 2); ss += __shfl_xor(ss, 4);
            const float rstd = 1.0f / sqrtf(ss * (1.f / HD) + EPS);
            GAS f32x4* o = (GAS f32x4*)(ko + lane * 16);
            if (tok >= SEQ) {
#pragma unroll
                for (int j = 0; j < 4; ++j) __builtin_nontemporal_store((f32x4){f[4 * j] * rstd * g[j][0], f[4 * j + 1] * rstd * g[j][1], f[4 * j + 2] * rstd * g[j][2], f[4 * j + 3] * rstd * g[j][3]}, o + j);
            } else {
#pragma unroll
                for (int j = 0; j < 4; ++j) __builtin_nontemporal_store((f32x4){f[4 * j], f[4 * j + 1], f[4 * j + 2], f[4 * j + 3]}, o + j); }
            unpack8(vw[q][0], f); unpack8(vw[q][1], f + 8);
            GAS f32x4* ov = (GAS f32x4*)(vo + lane * 16);
#pragma unroll
            for (int j = 0; j < 4; ++j) __builtin_nontemporal_store((f32x4){f[4 * j], f[4 * j + 1], f[4 * j + 2], f[4 * j + 3]}, ov + j); }
    } else {
        const int tb = (item - PL_KV) * 16;
#pragma unroll 2
        for (int it = tid; it < 16 * (DCONV / 8); it += NTHR) {
            const int tok = tb + (it >> 7), c8 = (it & 127) * 8;
            const bool samp = tok >= SEQ; const int b = (tok - SEQ) >> 3, i = samp ? ((tok - SEQ) & 7) : tok;
            v4u xw[3], cw[3]; f32x4 s0[2], s1[2];
#pragma unroll
            for (int k = 0; k < 3; ++k) { const int ii = i - 2 + k; const bf16* pr = PROJ + (size_t)(tok - 2 + k) * DIN;
                if (ii >= 0) { xw[k] = *(const GAS v4u*)(pr + c8); cw[k] = *(const GAS v4u*)(pr + 2048 + c8); } else { xw[k] = (v4u){0u, 0u, 0u, 0u}; cw[k] = (v4u){0u, 0u, 0u, 0u}; } }
            if (samp && i < 2) { const float* st = A.state_conv + ((size_t)b * 2) * DCONV + c8; s0[0] = *(const GAS f32x4*)(st); s0[1] = *(const GAS f32x4*)(st + 4); s1[0] = *(const GAS f32x4*)(st + DCONV); s1[1] = *(const GAS f32x4*)(st + DCONV + 4); }
            const v4u bw = *(const GAS v4u*)(PROJ + (size_t)tok * DIN + 1024 + c8);
            float u[3][8];
#pragma unroll
            for (int k = 0; k < 3; ++k) { float xc[8], cg[8]; unpack8(xw[k], xc); unpack8(cw[k], cg);
#pragma unroll
                for (int j = 0; j < 8; ++j) u[k][j] = cg[j] * xc[j]; }
            if (samp && i < 2) {
#pragma unroll
                for (int j = 0; j < 8; ++j) { const float st0 = j < 4 ? s0[0][j] : s0[1][j - 4], st1 = j < 4 ? s1[0][j] : s1[1][j - 4];
                    if (i == 0) { u[0][j] = st0; u[1][j] = st1; } else { u[0][j] = st1; } } }
            float bg[8]; unpack8(bw, bg);
            float y[8];
#pragma unroll
            for (int j = 0; j < 8; ++j) y[j] = bg[j] * (u[0][j] * A.conv_w[c8 + j] + u[1][j] * A.conv_w[DCONV + c8 + j] + u[2][j] * A.conv_w[2 * DCONV + c8 + j]);
            v4u w; w.x = pk2(y[0], y[1]); w.y = pk2(y[2], y[3]); w.z = pk2(y[4], y[5]); w.w = pk2(y[6], y[7]);
            *(GAS v4u*)(MIX + (size_t)tok * DM + c8) = w;
            float* co = nullptr;
            if (samp) { if (i >= 6) co = A.out + O_SC + ((size_t)b * 2 + (i - 6)) * DCONV + c8; }
            else if (tok >= SEQ - 2) co = A.out + O_PC + (size_t)(tok - (SEQ - 2)) * DCONV + c8;
            if (co) {
#pragma unroll
                for (int j = 0; j < 8; ++j) co[j] = u[2][j]; }
        }
    }
}
__device__ __forceinline__ int att_mult(int dist) { return (dist <= 128 ? 1 : 0) + (((dist & 3) == 0 && dist <= 512) ? 1 : 0) + (((dist & 15) == 0 && dist <= 2048) ? 1 : 0); }
constexpr int SROWS = 1288, S_TBL = 0, S_Q = 8256, S_P = S_Q + 4096, S_OP = S_P + SROWS * 32, S_LP = S_OP + 65536, S_KT = 122880, S_END = S_KT + 32768;
__device__ __forceinline__ void attn_sample_unit(const Args& A, LAS unsigned char* lds, int b, int h, float Mp) {
    const int tid = opaque_tid(), lane = tid & 63, wave = __builtin_amdgcn_readfirstlane(tid >> 6);
    const bf16* PROJ = (const bf16*)(A.ws + WS_PROJ); const bf16* QN = (const bf16*)(A.ws + WS_QN); const bf16* KN = (const bf16*)(A.ws + WS_KN); bf16* MIX = (bf16*)(A.ws + WS_MIX);
    LAS float* tblS = (LAS float*)(lds + S_TBL); LAS float* q_s = (LAS float*)(lds + S_Q); LAS float* P_T = (LAS float*)(lds + S_P); LAS float* Opart = (LAS float*)(lds + S_OP); LAS float* lpart = (LAS float*)(lds + S_LP);
    __syncthreads();
    {
        LAS float* rb = q_s; LAS unsigned* bkw = (LAS unsigned*)(q_s + 32);
        if (tid < 32) rb[tid] = A.rel_bias[tid * NH + h] * LOG2E - Mp;
        else if (tid < 32 + 99) bkw[tid - 32] = ((const unsigned*)&BUCKET[0][0])[tid - 32];
        __syncthreads();
        const LAS unsigned char* bkb = (const LAS unsigned char*)bkw;
        for (int x = tid; x < 2064; x += NTHR) { float v = -1e30f;
            if (x <= 2055) { const int c = att_mult(x); if (c > 0) { const int bk = x <= 128 ? bkb[x] : (((x & 3) == 0 && x <= 512) ? bkb[132 + (x >> 2)] : bkb[264 + (x >> 4)]);
                v = (c == 1 ? 0.f : (c == 2 ? 1.f : 1.5849625007211562f)) + rb[bk]; } }
            tblS[x] = v; }
    }
    __syncthreads();
    {
        const int li = lane & 15, quad = lane >> 4;
        bf16x8 qf[4];
#pragma unroll
        for (int ks = 0; ks < 4; ++ks) qf[ks] = (bf16x8){0, 0, 0, 0, 0, 0, 0, 0};
        load_q_frags(qf, PROJ + (size_t)(SEQ + b * 8 + (li & 7)) * DIN + 3072 + h * HD, A.q_norm, quad);
        const float* kbase = A.cache_k + ((size_t)b * WBUF * NH + h) * HD + 4 * (lane & 31);
        f32x4 ka[8], kb[8];
        const int half_ = lane >> 5, l32_ = lane & 31;
        LAS unsigned char* ktile = lds + S_KT + wave * 4096;
#define SC_LOAD(dst, ti) do { _Pragma("unroll") for (int x_ = 0; x_ < 8; ++x_) { const int n_ = 16 * (ti) + 2 * x_ + half_, p_ = n_ < 768 ? ((n_ >> 3) * 16 + (n_ & 7)) : n_ + 768; \
            dst[x_] = __builtin_nontemporal_load((const GAS f32x4*)(kbase + (size_t)p_ * (NH * HD))); } } while (0)
#define SC_TILE(src_, ti) do { f32x4 s_ = (f32x4){0.f, 0.f, 0.f, 0.f}; \
        _Pragma("unroll") for (int x_ = 0; x_ < 8; ++x_) { const int row_ = 2 * x_ + half_; v2u w_; w_.x = pg8::cvt_pk_bf16(src_[x_][0], src_[x_][1]); w_.y = pg8::cvt_pk_bf16(src_[x_][2], src_[x_][3]); \
            *(LAS v2u*)(ktile + row_ * 256 + 16 * ((l32_ >> 1) ^ row_) + 8 * (l32_ & 1)) = w_; }              \
        asm volatile("s_waitcnt lgkmcnt(0)" ::: "memory"); \
        _Pragma("unroll") for (int ks = 0; ks < 4; ++ks) { const bf16x8 kf_ = *(const LAS bf16x8*)(ktile + li * 256 + 16 * ((4 * ks + quad) ^ li)); \
            s_ = __builtin_amdgcn_mfma_f32_16x16x32_bf16(kf_, qf[ks], s_, 0, 0, 0); } \
        if (li < 8) { _Pragma("unroll") for (int rg = 0; rg < 4; ++rg) { const int n_ = 16 * (ti) + 4 * quad + rg, p_ = n_ < 768 ? ((n_ >> 3) * 16 + (n_ & 7)) : n_ + 768, dist_ = WBUF + li - p_; \
            P_T[n_ * 8 + li] = __builtin_amdgcn_exp2f(s_[rg] + tblS[dist_ < 0 ? 2056 : dist_]); } } } while (0)
        SC_LOAD(ka, wave);
#pragma unroll 1
        for (int k = 0; k < 8; k += 2) {
            SC_LOAD(kb, wave + NWAVES * (k + 1));
            SC_TILE(ka, wave + NWAVES * k);
            SC_LOAD(ka, wave + NWAVES * (k + 2));
            SC_TILE(kb, wave + NWAVES * (k + 1));
        }
        SC_LOAD(kb, wave + NWAVES * 9);
        SC_TILE(ka, wave + NWAVES * 8);
        SC_TILE(kb, wave + NWAVES * 9);
#undef SC_LOAD
#undef SC_TILE
        if (wave == 0) {
            f32x4 s_ = (f32x4){0.f, 0.f, 0.f, 0.f};
            bf16x8 kn[4]; load_q_frags(kn, PROJ + (size_t)(SEQ + b * 8 + (li & 7)) * DIN + 4096 + h * HD, A.k_norm, quad, 1.0f);
#pragma unroll
            for (int ks = 0; ks < 4; ++ks) s_ = __builtin_amdgcn_mfma_f32_16x16x32_bf16(kn[ks], qf[ks], s_, 0, 0, 0);
            if (li < 8 && quad < 2) {
#pragma unroll
                for (int rg = 0; rg < 4; ++rg) { const int rr = 4 * quad + rg, dist_ = li - rr; P_T[(SROWS - 8 + rr) * 8 + li] = __builtin_amdgcn_exp2f(s_[rg] + tblS[dist_ < 0 ? 2056 : dist_]); } }
        }
    }
    __syncthreads();
    {
        const int half = lane >> 5, l32 = lane & 31;
        f32x4 o[8]; float la[8];
#pragma unroll
        for (int i = 0; i < 8; ++i) { o[i] = (f32x4){0.f, 0.f, 0.f, 0.f}; la[i] = 0.f; }
        const float* vbase = A.cache_v + ((size_t)b * WBUF * NH + h) * HD + 4 * l32;
        f32x4 va[8], vb[8];
#define PV_LOAD(dst, k0) do { _Pragma("unroll") for (int u = 0; u < 8; ++u) { const int n_ = 2 * (wave + NWAVES * ((k0) + u)) + half, p_ = n_ < 768 ? ((n_ >> 3) * 16 + (n_ & 7)) : n_ + 768; dst[u] = __builtin_nontemporal_load((const GAS f32x4*)(vbase + (size_t)p_ * (NH * HD))); } } while (0)
#define PV_ACC(src_, k0) do { _Pragma("unroll") for (int u = 0; u < 8; ++u) { const int n_ = 2 * (wave + NWAVES * ((k0) + u)) + half; \
            const f32x4 pa = *(const LAS f32x4*)(P_T + n_ * 8), pb = *(const LAS f32x4*)(P_T + n_ * 8 + 4); \
            _Pragma("unroll") for (int i = 0; i < 4; ++i) { o[i] += src_[u] * pa[i]; la[i] += pa[i]; o[4 + i] += src_[u] * pb[i]; la[4 + i] += pb[i]; } } } while (0)
        PV_LOAD(va, 0);
#pragma unroll 1
        for (int k0 = 0; k0 < 64; k0 += 16) {
            PV_LOAD(vb, k0 + 8);
            PV_ACC(va, k0);
            PV_LOAD(va, k0 + 16);
            PV_ACC(vb, k0 + 8);
        }
        PV_LOAD(vb, 72);
        PV_ACC(va, 64);
        PV_ACC(vb, 72);
#undef PV_LOAD
#undef PV_ACC
        if (wave < 4) {
            const int n = SROWS - 8 + 2 * wave + half; const v2u w = *(const GAS v2u*)(PROJ + (size_t)(SEQ + b * 8 + (n - (SROWS - 8))) * DIN + 5120 + h * HD + 4 * l32);
            const f32x4 vv = (f32x4){bf_lo(w.x), bf_hi(w.x), bf_lo(w.y), bf_hi(w.y)};
            const f32x4 pa = *(const LAS f32x4*)(P_T + n * 8), pb = *(const LAS f32x4*)(P_T + n * 8 + 4);
#pragma unroll
            for (int i = 0; i < 4; ++i) { o[i] += vv * pa[i]; la[i] += pa[i]; o[4 + i] += vv * pb[i]; la[4 + i] += pb[i]; }
        }
        const int hw = wave * 2 + half;
#pragma unroll
        for (int i = 0; i < 8; ++i) { *(LAS f32x4*)(Opart + (hw * 8 + i) * 128 + 4 * l32) = o[i]; if (l32 == 0) lpart[hw * 8 + i] = la[i]; }
    }
    __syncthreads();
    {   const int i = tid >> 6, d = 2 * (tid & 63); float a0 = 0.f, a1 = 0.f, l = 0.f;
#pragma unroll
        for (int w = 0; w < 2 * NWAVES; ++w) { const f32x2 v = *(const LAS f32x2*)(Opart + (w * 8 + i) * 128 + d); a0 += v.x; a1 += v.y; l += lpart[w * 8 + i]; }
        const float inv = 1.0f / l;
        *(GAS unsigned*)(MIX + (size_t)(SEQ + b * 8 + i) * DM + DATT + h * HD + d) = pk2(a0 * inv, a1 * inv);
    }
}
__device__ __forceinline__ void phase_attn(const Args& A, LAS unsigned char* lds, int vcu, int G) {
    const float Mp = softmax_bound_l2(A, threadIdx.x & 63);
    for (int pass = 0; pass < 2; ++pass) {
        const bool prompt = ((vcu & 1) == 0) == (pass == 0);
#ifndef REP_PR
#define REP_PR 1
#endif
#ifndef REP_SA
#define REP_SA 1
#endif
        if (prompt) { for (int rep = 0; rep < REP_PR; ++rep) for (int u = vcu; u < NH * (SEQ / 256); u += G) attn2_prompt_unit(A, lds, u >> 5, ((u & 31) >> 1) + 16 * (u & 1), Mp); }
        else { for (int rep = 0; rep < REP_SA; ++rep) for (int u = vcu; u < DBATCH * NH; u += G) attn_sample_unit(A, lds, u >> 3, u & 7, Mp); }
    }
    volatile LAS int* qslot = (volatile LAS int*)(lds + LDS_ST_OFF + 16);
    for (;;) {
        __syncthreads();
        if (threadIdx.x == 0) *qslot = (int)__hip_atomic_fetch_add((unsigned*)(A.ws + WS_CTL), 1u, __ATOMIC_RELAXED, __HIP_MEMORY_SCOPE_AGENT);
        __syncthreads();
        const int item = *qslot;
        if (item >= PL_ITEMS + PL_GU) break;
        if (item < PL_ITEMS) postlite_item(A, item); else convert_gu_item(A, lds, item - PL_ITEMS);
    }
}

template <int N> __device__ __forceinline__ void wait_vm() { asm volatile("s_waitcnt vmcnt(%0)" :: "n"(N) : "memory"); }
template <int MB, int NB, int KC, int NSLOT, int NCH, class Epi>
__device__ __forceinline__ void skinny2(const bf16* A, const bf16* Bt, int tile, LAS unsigned char* lds, const Epi& E) {
    constexpr int K = KC * NCH, RT = 256 / (16 * MB), W = 16 * NB, R = 16 * (MB + NB), ROWB = KC * 2, CHB = R * ROWB, LPR = ROWB / 16, RPI = 64 / LPR, NI = R / RPI, NL = NI / 8, NJ = MB * NB / 8, KS = KC / 32;
    static_assert(NI % 8 == 0 && NSLOT * CHB <= 131072 && (MB * NB) % 8 == 0 && 8 % MB == 0 && LPR >= 16 && NSLOT >= 3, "skinny2 shape");
    const int tid = opaque_tid(), lane = tid & 63, wave = __builtin_amdgcn_readfirstlane(tid >> 6), fr = lane & 15, fq = lane >> 4;
    const int rt = tile % RT, ct = tile / RT;
    const bf16* gp[NL];
#pragma unroll
    for (int i = 0; i < NL; ++i) { const int q = wave + 8 * i, row = q * RPI + lane / LPR, piece = (lane % LPR) ^ (row & 15);
        const bf16* rp = row < 16 * MB ? A + (size_t)(16 * MB * rt + row) * K : Bt + (size_t)(W * ct + row - 16 * MB) * K; gp[i] = rp + 8 * piece; }
    const int mi = wave % MB, g = wave / MB;
    f32x4 acc[NJ];
#pragma unroll
    for (int j = 0; j < NJ; ++j) acc[j] = (f32x4){0.f, 0.f, 0.f, 0.f};
    const unsigned aoff = (unsigned)(16 * mi + fr) * ROWB, boff = (unsigned)(16 * MB + 16 * NJ * g + fr) * ROWB;
#define SK2_STAGE(c) do { _Pragma("unroll") for (int i_ = 0; i_ < NL; ++i_) __builtin_amdgcn_global_load_lds((const unsigned*)(gp[i_] + (size_t)(c) * KC), (LAS unsigned*)(lds + ((c) % NSLOT) * CHB + (wave + 8 * i_) * 1024), 16, 0, 0); } while (0)
#pragma unroll
    for (int c = 0; c < NSLOT - 1; ++c) if (c < NCH) SK2_STAGE(c);
#pragma unroll
    for (int c = 0; c < NCH; ++c) {
        const int ahead = (NCH - 1 - c) < (NSLOT - 2) ? (NCH - 1 - c) : (NSLOT - 2);
        if (ahead >= 2) wait_vm<2 * NL>(); else if (ahead == 1) wait_vm<NL>(); else wait_vm<0>();
        __builtin_amdgcn_s_barrier(); asm volatile("" ::: "memory");
        if (c + NSLOT - 1 < NCH) SK2_STAGE(c + NSLOT - 1);
        const LAS unsigned char* sb = lds + (c % NSLOT) * CHB;
#pragma unroll
        for (int kk = 0; kk < KS; ++kk) { const unsigned po = 16u * (unsigned)((4 * kk + fq) ^ fr);
            const bf16x8 af = *(const LAS bf16x8*)(sb + aoff + po);
#pragma unroll
            for (int j = 0; j < NJ; ++j) { const bf16x8 bf = *(const LAS bf16x8*)(sb + boff + j * 16 * ROWB + po); acc[j] = __builtin_amdgcn_mfma_f32_16x16x32_bf16(bf, af, acc[j], 0, 0, 0); } }
    }
#undef SK2_STAGE
    asm volatile("s_waitcnt lgkmcnt(0)" ::: "memory");
    __syncthreads();
#pragma unroll
    for (int j = 0; j < NJ; ++j) *(LAS f32x4*)(lds + ((16 * mi + fr) * W + 16 * (NJ * g + j) + 4 * fq) * 4) = acc[j];
    __syncthreads();
    constexpr int NCHK = 16 * MB * W / 4;
#pragma unroll
    for (int i = 0; i < NCHK / NTHR; ++i) { const int ch = tid + NTHR * i, row = ch / (W / 4), c4 = ch % (W / 4);
        const f32x4 v = *(const LAS f32x4*)(lds + (row * W + 4 * c4) * 4);
        E(16 * MB * rt + row, W * ct + 4 * c4, ct, v); }
    __syncthreads();
}
struct SkProj { bf16* PROJ; __device__ __forceinline__ void operator()(int row, int col, int, f32x4 v) const { v2u w; w.x = pg8::cvt_pk_bf16(v[0], v[1]); w.y = pg8::cvt_pk_bf16(v[2], v[3]); *(GAS v2u*)(PROJ + (size_t)(SEQ + row) * DIN + col) = w; } };
struct SkRes1 { const float* xs; bf16* X1b; float* SSQ;
    __device__ __forceinline__ void operator()(int row, int col, int ct, f32x4 v) const {
        const f32x4 o = *(const GAS f32x4*)(xs + (size_t)row * DM + col) + v; const size_t off = (size_t)(SEQ + row) * DM + col;
        v2u pk; pk.x = pg8::cvt_pk_bf16(o[0], o[1]); pk.y = pg8::cvt_pk_bf16(o[2], o[3]); *(GAS v2u*)(X1b + off) = pk;
        float ss = (o[0] * o[0] + o[1] * o[1]) + (o[2] * o[2] + o[3] * o[3]); ss += __shfl_xor(ss, 1); ss += __shfl_xor(ss, 2); ss += __shfl_xor(ss, 4); ss += __shfl_xor(ss, 8);
        if ((threadIdx.x & 15) == 0) SSQ[(size_t)(SEQ + row) * 32 + ct] = ss; } };
struct SkOut { const bf16* X1b; float* out; __device__ __forceinline__ void operator()(int row, int col, int, f32x4 v) const { const size_t off = (size_t)(SEQ + row) * DM + col; const v2u w = *(const GAS v2u*)(X1b + off);
        *(GAS f32x4*)(out + off) = (f32x4){bf_lo(w.x), bf_hi(w.x), bf_lo(w.y), bf_hi(w.y)} + v; } };

#define XB_TMO      128
#define XB_XCNT(j)  (256  + 64 * (j))
#define XB_XSUB(j)  (1280 + 64 * (j))
#define XB_XGEN(j)  (2304 + 64 * (j))
#define XB_TOP      3328
#define XB_TOPGEN   3392
#define XCD_BAR_WORDS 3456
#define XB_SPIN_CAP (1u << 18)
__device__ __forceinline__ unsigned xb_ld(unsigned* p)              { return __hip_atomic_load(p, __ATOMIC_RELAXED, __HIP_MEMORY_SCOPE_AGENT); }
__device__ __forceinline__ unsigned xb_add(unsigned* p, unsigned v) { return __hip_atomic_fetch_add(p, v, __ATOMIC_RELAXED, __HIP_MEMORY_SCOPE_AGENT); }
__device__ __forceinline__ unsigned xb_xcc_id() { return (unsigned)__builtin_amdgcn_s_getreg((3 << 11) | 20) & 0xFu; }
#define XB_SPIN(cond, bar) do { unsigned _sp = 0; while (cond) { __builtin_amdgcn_s_sleep(1); \
    if ((++_sp & 255u) == 0u) { if (xb_ld(&(bar)[XB_TMO])) break; if (_sp > XB_SPIN_CAP) { atomicAdd(&(bar)[XB_TMO], 1u); break; } } } } while (0)
struct XcdBarrier { unsigned* bar; unsigned x; volatile LAS unsigned* st; };
__device__ __forceinline__ XcdBarrier xcd_barrier_post(unsigned* bar, volatile LAS unsigned* st) {
    XcdBarrier b; b.bar = bar; b.x = xb_xcc_id(); b.st = st;
    if (threadIdx.x == 0) (void)xb_add(&bar[XB_XCNT(b.x)], 1u);
    return b;
}
__device__ __forceinline__ void xcd_barrier_complete(unsigned* bar, unsigned x, unsigned& nloc, unsigned& nx) {
    const unsigned G = gridDim.x * gridDim.y * gridDim.z;
    unsigned sum, cnt, mine, sp = 0u;
    for (;;) {
        sum = 0u; cnt = 0u; mine = 0u;
#pragma unroll
        for (unsigned j = 0; j < 16; ++j) { const unsigned c = xb_ld(&bar[XB_XCNT(j)]); sum += c; cnt += (c > 0u) ? 1u : 0u; mine = (j == x) ? c : mine; }
        if (sum == G) break;
        __builtin_amdgcn_s_sleep(1);
        if ((++sp & 255u) == 0u) { if (xb_ld(&bar[XB_TMO])) break; if (sp > XB_SPIN_CAP) { atomicAdd(&bar[XB_TMO], 1u); break; } }
    }
    nloc = mine > 0u ? mine : 1u; nx = cnt > 0u ? cnt : 1u;
}
__device__ __forceinline__ void xcd_barrier(const XcdBarrier& b) {
    asm volatile("s_waitcnt vmcnt(0)" ::: "memory");
    __syncthreads();
    if (threadIdx.x == 0) {
        unsigned* bar = b.bar;
        __builtin_amdgcn_s_waitcnt(0);
        unsigned nloc = b.st[0], nx = b.st[1];
        if (nloc == 0u) { xcd_barrier_complete(bar, b.x, nloc, nx); b.st[0] = nloc; b.st[1] = nx; }
        const unsigned old = xb_add(&bar[XB_XSUB(b.x)], 1u);
        const unsigned gen = old / nloc;
        if (old + 1u == (gen + 1u) * nloc) {
            __builtin_amdgcn_fence(__ATOMIC_RELEASE, "agent");
            asm volatile("s_waitcnt vmcnt(0)" ::: "memory");
            const unsigned og = xb_add(&bar[XB_TOP], 1u);
            const unsigned tg = og / nx;
            if (og + 1u == (tg + 1u) * nx) xb_add(&bar[XB_TOPGEN], 1u);
            else XB_SPIN(xb_ld(&bar[XB_TOPGEN]) == tg, bar);
            __builtin_amdgcn_fence(__ATOMIC_ACQUIRE, "agent");
            xb_add(&bar[XB_XGEN(b.x)], 1u);
            asm volatile("s_waitcnt vmcnt(0)" ::: "memory");
        } else {
            XB_SPIN(xb_ld(&bar[XB_XGEN(b.x)]) == gen, bar);
            __builtin_amdgcn_fence(__ATOMIC_ACQUIRE, "agent");
            asm volatile("s_waitcnt vmcnt(0)" ::: "memory");
        }
    }
    __syncthreads();
}
constexpr int CW_BAR = 4096;
constexpr size_t CTL_ZERO_BYTES = 65536;

namespace cg = cooperative_groups;
__device__ __forceinline__ int vcu_of(int bx, int G) { return (G % 8 == 0) ? (bx % 8) * (G / 8) + bx / 8 : bx; }
__global__ void __launch_bounds__(NTHR, 2) fwd_mega(Args A) {
    extern __shared__ __attribute__((aligned(16))) unsigned char lds_raw[];
    LAS unsigned char* lds = (LAS unsigned char*)lds_raw;
    const int G = gridDim.x, bx = blockIdx.x, vcu = vcu_of(bx, G);
    volatile LAS unsigned* st = (volatile LAS unsigned*)(lds + LDS_ST_OFF);
    if (threadIdx.x < 2) st[threadIdx.x] = 0u;
    __syncthreads();
    const XcdBarrier bar = xcd_barrier_post((unsigned*)(A.ws + WS_CTL) + CW_BAR, st);
#if defined(MK_CG_SYNC)
    cg::grid_group grid = cg::this_grid();
#define SEAM() grid.sync()
#else
#define SEAM() xcd_barrier(bar)
#endif
#ifndef REP_G1
#define REP_G1 1
#endif
#ifndef REP_G1S
#define REP_G1S 1
#endif
#ifndef REP_G2
#define REP_G2 1
#endif
#ifndef REP_G2S
#define REP_G2S 1
#endif
#ifndef REP_G3
#define REP_G3 1
#endif
#ifndef REP_G4
#define REP_G4 1
#endif
#ifndef REP_G4S
#define REP_G4S 1
#endif
#ifndef REP_P0
#define REP_P0 1
#endif
#ifndef REP_P2
#define REP_P2 1
#endif
#ifndef REP_P3
#define REP_P3 1
#endif
    for (int rep = 0; rep < REP_P0; ++rep) phase_prologue(A, lds, vcu, G);
    SEAM();
#pragma unroll 1
    for (int pass_ = 0; pass_ < 2; ++pass_) { if ((pass_ == 0) == ((vcu & 1) == 0)) {
for (int rep_ = 0; rep_ < REP_G1; ++rep_) { pg8::Gemm g{(const bf16*)(A.ws + WS_XN), (const bf16*)(A.ws + WS_WIN), SEQ, DIN, DM}; pg8::StaticOrder S; S.init(SEQ, DIN, G, bx);
      pg8::EpiProj E{(bf16*)(A.ws + WS_PROJ), DIN, (bf16*)(A.ws + WS_QN), (bf16*)(A.ws + WS_KN), A.q_norm, A.k_norm, A.out + O_PK, A.out + O_PV, (LAS float*)(lds + 135168)}; pg8::gemm_phase<pg8::EpiProj, pg8::StaticOrder, true, true>(lds, g, S, E); }
    } else {
for (int rep_ = 0; rep_ < REP_G1S; ++rep_) for (int t = vcu; t < 256; t += G) skinny2<4, 6, 128, 3, DM / 128>((const bf16*)(A.ws + WS_XN) + (size_t)SEQ * DM, (const bf16*)(A.ws + WS_WIN), t, lds, SkProj{(bf16*)(A.ws + WS_PROJ)});
    } }
    SEAM();
    for (int rep = 0; rep < REP_P3; ++rep) phase_attn(A, lds, vcu, G);
    SEAM();
#pragma unroll 1
    for (int pass_ = 0; pass_ < 2; ++pass_) { if ((pass_ == 0) == ((vcu & 1) == 0)) {
for (int rep_ = 0; rep_ < REP_G2; ++rep_) { pg8::Gemm g{(const bf16*)(A.ws + WS_MIX), (const bf16*)(A.ws + WS_WOUT), SEQ, DM, DM}; pg8::StaticOrder S; S.init(SEQ, DM, G, bx);
      pg8::EpiRes1 E{A.x_prompt, (bf16*)(A.ws + WS_XN2), (float*)(A.ws + WS_SSQ)}; pg8::gemm_phase<pg8::EpiRes1, pg8::StaticOrder, true, true>(lds, g, S, E); }
    } else {
for (int rep_ = 0; rep_ < REP_G2S; ++rep_) for (int t = vcu; t < 256; t += G) skinny2<2, 4, 128, 4, DM / 128>((const bf16*)(A.ws + WS_MIX) + (size_t)SEQ * DM, (const bf16*)(A.ws + WS_WOUT), t, lds, SkRes1{A.x_sample, (bf16*)(A.ws + WS_XN2), (float*)(A.ws + WS_SSQ)});
    } }
    SEAM();
for (int rep_ = 0; rep_ < REP_G3; ++rep_) { pg8::Gemm g{(const bf16*)(A.ws + WS_XN2), (const bf16*)(A.ws + WS_WGU), MT, NGU, DM}; pg8::StaticOrder S; S.init(MT, NGU, G, bx);
      pg8::EpiSwiGLU E{(const float*)(A.ws + WS_SSQ), (bf16*)(A.ws + WS_H)}; pg8::gemm_phase<pg8::EpiSwiGLU, pg8::StaticOrder, true, true>(lds, g, S, E); }
    { constexpr int NU3 = (MT / 256) * (NGU / 256); const int full = NU3 % G;
      if (full != 0 && bx >= full) convert_wdown(A, lds, bx - full, G - full); else if (full == 0) convert_wdown(A, lds, bx, G); }
    SEAM();
#pragma unroll 1
    for (int pass_ = 0; pass_ < 2; ++pass_) { if ((pass_ == 0) == ((vcu & 1) == 0)) {
for (int rep_ = 0; rep_ < REP_G4; ++rep_) { pg8::Gemm g{(const bf16*)(A.ws + WS_H), (const bf16*)(A.ws + WS_WDN), SEQ, DM, DFF}; pg8::StaticOrder S; S.init(SEQ, DM, G, bx);
      pg8::EpiOut E{(const bf16*)(A.ws + WS_XN2), A.out + O_Y}; pg8::gemm_phase<pg8::EpiOut, pg8::StaticOrder, true, true>(lds, g, S, E); }
    } else {
for (int rep_ = 0; rep_ < REP_G4S; ++rep_) for (int t = vcu; t < 256; t += G) skinny2<2, 4, 128, 4, DFF / 128>((const bf16*)(A.ws + WS_H) + (size_t)SEQ * DFF, (const bf16*)(A.ws + WS_WDN), t, lds, SkOut{(const bf16*)(A.ws + WS_XN2), A.out + O_Y});
    } }
}

extern "C" void kernel_launch(void* const* d_in, const int* in_sizes, int n_in, void* d_out, int out_size, void* d_ws, size_t ws_size, hipStream_t stream) {
    static int grid = 0;
    if (grid == 0) {
        if (n_in != 16 || (size_t)out_size != O_END || ws_size < WS_END) { fprintf(stderr, "kernel_launch: unexpected shapes: n_in %d out %d ws %zu\n", n_in, out_size, ws_size); grid = -1; return; }
        int dev = 0, cus = 0, per_cu = 0;
        if (hipGetDevice(&dev) != hipSuccess || hipDeviceGetAttribute(&cus, hipDeviceAttributeMultiprocessorCount, dev) != hipSuccess) { grid = -1; return; }
        if (hipFuncSetAttribute((const void*)fwd_mega, hipFuncAttributeMaxDynamicSharedMemorySize, LDS_BYTES) != hipSuccess) { fprintf(stderr, "kernel_launch: hipFuncSetAttribute failed\n"); grid = -1; return; }
        if (hipOccupancyMaxActiveBlocksPerMultiprocessor(&per_cu, (const void*)fwd_mega, NTHR, LDS_BYTES) != hipSuccess || per_cu < 1) { fprintf(stderr, "kernel_launch: occupancy query failed (%d)\n", per_cu); (void)hipGetLastError(); per_cu = 1; }
        if (per_cu > 1) per_cu = 1;
        grid = cus * per_cu;
    }
    if (grid < 0) return;
    Args a{};
    a.x_prompt = (const float*)d_in[0]; a.x_sample = (const float*)d_in[1]; a.cache_k = (const float*)d_in[2]; a.cache_v = (const float*)d_in[3]; a.state_conv = (const float*)d_in[4]; a.norm_mix = (const float*)d_in[5];
    a.w_in = (const float*)d_in[6]; a.conv_w = (const float*)d_in[7]; a.q_norm = (const float*)d_in[8]; a.k_norm = (const float*)d_in[9]; a.rel_bias = (const float*)d_in[10]; a.w_out = (const float*)d_in[11];
    a.norm_ffn = (const float*)d_in[12]; a.w_gate = (const float*)d_in[13]; a.w_up = (const float*)d_in[14]; a.w_down = (const float*)d_in[15];
    a.out = (float*)d_out; a.ws = (unsigned char*)d_ws;
    if (hipMemsetAsync((char*)d_ws + WS_CTL, 0, CTL_ZERO_BYTES, stream) != hipSuccess) { fprintf(stderr, "kernel_launch: memset of the control words failed\n"); return; }
    void* args[] = {&a};
    hipError_t e = hipLaunchCooperativeKernel((const void*)fwd_mega, dim3(grid), dim3(NTHR), args, LDS_BYTES, stream);
    if (e != hipSuccess) fprintf(stderr, "kernel_launch: cooperative launch failed: %s (grid %d)\n", hipGetErrorString(e), grid);
}
```
